# Optimizing an MI355X kernel written in HIP

```python
import jax, jax.numpy as jnp
from jax import lax
import numpy as np

D_MODEL = 1024
BATCH = 2
SEQ = 8192
DEPTH = 1

ATTN_WIDTH = D_MODEL // 2
ATTN_HEADS = 8
ATTN_HEAD_DIM = ATTN_WIDTH // ATTN_HEADS
DILATED_PAIRS = ((128, 1), (512, 4), (2048, 16))
ATTN_BLOCK = 128
ROPE_THETA = 10000.0
HGRN_WIDTH = D_MODEL - ATTN_WIDTH
HGRN_EXPAND = 128
HGRN_HEADS = HGRN_WIDTH // HGRN_EXPAND
HGRN_CHUNK = 16
MIX_WIDTH = ATTN_WIDTH + HGRN_WIDTH
IN_PROJ_WIDTH = 3 * ATTN_WIDTH + 4 * HGRN_WIDTH
FFN_HIDDEN = ((-(-8 * D_MODEL // 3) + 255) // 256) * 256
NORM_EPS = 1e-6

kernel_name = "hymba_dilated_attn_hgrn2_block"


def rmsnorm(x, w):
    xf = x.astype(jnp.float32)
    y = xf * lax.rsqrt(jnp.mean(xf * xf, axis=-1, keepdims=True) + NORM_EPS)
    return (y * w.astype(jnp.float32)).astype(x.dtype)


def rotary(x):
    S, Dh = x.shape[1], x.shape[3]
    half = Dh // 2
    inv_freq = ROPE_THETA ** (-jnp.arange(half, dtype=jnp.float32) / half)
    ang = jnp.arange(S, dtype=jnp.float32)[:, None] * inv_freq[None, :]
    cos = jnp.cos(ang)[None, :, None, :]
    sin = jnp.sin(ang)[None, :, None, :]
    xf = x.astype(jnp.float32)
    x1, x2 = xf[..., :half], xf[..., half:]
    return jnp.concatenate([x1 * cos - x2 * sin, x2 * cos + x1 * sin], axis=-1)


def dilated_window_attention(q, k, v, window, dilation):
    B, S, H, Dh = q.shape
    L = S // dilation
    W = window // dilation
    n_blk = -(-L // ATTN_BLOCK)
    Lp = n_blk * ATTN_BLOCK

    def to_blocks(t):
        t = t.reshape(B, L, dilation, H, Dh).transpose(0, 2, 1, 3, 4)
        t = jnp.pad(t, ((0, 0), (0, 0), (0, Lp - L), (0, 0), (0, 0)))
        return t.reshape(B, dilation, n_blk, ATTN_BLOCK, H, Dh)

    def with_prev(t):
        prev = jnp.pad(t, ((0, 0), (0, 0), (1, 0), (0, 0), (0, 0), (0, 0)))[:, :, :-1]
        return jnp.concatenate([prev, t], axis=3)

    qb = to_blocks(q)
    kc = with_prev(to_blocks(k))
    vc = with_prev(to_blocks(v))
    scores = jnp.einsum('bdnqhe,bdnkhe->bdnhqk', qb, kc) * (Dh ** -0.5)
    qi = jnp.arange(ATTN_BLOCK)[:, None]
    kj = jnp.arange(2 * ATTN_BLOCK)[None, :]
    delta = ATTN_BLOCK + qi - kj
    blk = jnp.arange(n_blk)[:, None, None]
    valid = (delta >= 0) & (delta <= W) & ((blk > 0) | (kj >= ATTN_BLOCK))[...]
    scores = jnp.where(valid[None, None, :, None], scores, -jnp.inf)
    m = jnp.max(scores, axis=-1, keepdims=True)
    p = jnp.exp(scores - m)
    s = jnp.sum(p, axis=-1, keepdims=True)
    out = jnp.einsum('bdnhqk,bdnkhe->bdnqhe', p, vc) / s.transpose(0, 1, 2, 4, 3, 5)
    lse = (m + jnp.log(s))[..., 0].transpose(0, 1, 2, 4, 3)
    out = out.reshape(B, dilation, Lp, H, Dh)[:, :, :L].transpose(0, 2, 1, 3, 4).reshape(B, S, H, Dh)
    lse = lse.reshape(B, dilation, Lp, H)[:, :, :L].transpose(0, 2, 1, 3).reshape(B, S, H)
    return out, lse


def dilated_attention_group(q, k, v):
    B, S, _ = q.shape
    qh = rotary(q.reshape(B, S, ATTN_HEADS, ATTN_HEAD_DIM))
    kh = rotary(k.reshape(B, S, ATTN_HEADS, ATTN_HEAD_DIM))
    vh = v.reshape(B, S, ATTN_HEADS, ATTN_HEAD_DIM).astype(jnp.float32)
    outs, lses = [], []
    for window, dilation in DILATED_PAIRS:
        o, l = dilated_window_attention(qh, kh, vh, window, dilation)
        outs.append(o)
        lses.append(l)
    weights = jax.nn.softmax(jnp.stack(lses, axis=0), axis=0)
    y = jnp.sum(weights[..., None] * jnp.stack(outs, axis=0), axis=0)
    return y.reshape(B, S, ATTN_WIDTH)


def hgrn2_group(q, f_logit, i, g, lb, norm_w):
    B, S, _ = q.shape
    H, Dk, C = HGRN_HEADS, HGRN_EXPAND, HGRN_CHUNK
    N = S // C
    f = lb + (1.0 - lb) * jax.nn.sigmoid(f_logit.astype(jnp.float32))
    log_f = jnp.log(f)
    key = 1.0 - f
    qf = jax.nn.silu(q.astype(jnp.float32))

    def chunks(t):
        return t.reshape(B, N, C, H, Dk).transpose(0, 3, 1, 2, 4)

    qc, kc, vc, lfc = chunks(qf), chunks(key), chunks(i.astype(jnp.float32)), chunks(log_f)
    b = jnp.cumsum(lfc, axis=3)
    causal = jnp.tril(jnp.ones((C, C), dtype=bool))
    diff = b[:, :, :, :, None, :] - b[:, :, :, None, :, :]
    decay = jnp.exp(jnp.where(causal[:, :, None], diff, -jnp.inf))
    scores = jnp.einsum('bhntd,bhnsd,bhntsd->bhnts', qc, kc, decay)
    o_intra = jnp.einsum('bhnts,bhnsv->bhntv', scores, vc)

    b_last = b[:, :, :, -1:, :]
    q_inter = qc * jnp.exp(b)
    k_upd = kc * jnp.exp(b_last - b)
    chunk_decay = jnp.exp(b_last[:, :, :, 0, :])

    def step(state, xs):
        qn, kn, vn, dn = xs
        o = jnp.einsum('bhtd,bhdv->bhtv', qn, state)
        state = dn[..., None] * state + jnp.einsum('bhtd,bhtv->bhdv', kn, vn)
        return state, o

    xs = (jnp.moveaxis(q_inter, 2, 0), jnp.moveaxis(k_upd, 2, 0),
          jnp.moveaxis(vc, 2, 0), jnp.moveaxis(chunk_decay, 2, 0))
    state0 = jnp.zeros((B, H, Dk, Dk), dtype=jnp.float32)
    _, o_inter = lax.scan(step, state0, xs)
    o = o_intra + jnp.moveaxis(o_inter, 0, 2)
    o = o.transpose(0, 2, 3, 1, 4).reshape(B, S, H, Dk)
    o = o * lax.rsqrt(jnp.mean(o * o, axis=-1, keepdims=True) + NORM_EPS)
    o = o.reshape(B, S, HGRN_WIDTH) * norm_w.astype(jnp.float32)
    return o * jax.nn.silu(g.astype(jnp.float32))


def setup_inputs(seed: int = 0) -> dict:
    key = jax.random.key(seed)
    ks = jax.random.split(key, 10)
    f32 = jnp.float32
    x = jax.random.normal(ks[0], (BATCH, SEQ, D_MODEL), f32)
    norm1_w = 1.0 + 0.02 * jax.random.normal(ks[1], (DEPTH, D_MODEL), f32)
    w_in = jax.random.normal(ks[2], (DEPTH, D_MODEL, IN_PROJ_WIDTH), f32) * D_MODEL ** -0.5
    lb_logits = 0.5 * jax.random.normal(ks[3], (DEPTH + 1, HGRN_WIDTH), f32)
    hgrn_norm_w = 1.0 + 0.02 * jax.random.normal(ks[4], (DEPTH, HGRN_WIDTH), f32)
    w_out = jax.random.normal(ks[5], (DEPTH, MIX_WIDTH, D_MODEL), f32) * MIX_WIDTH ** -0.5
    norm2_w = 1.0 + 0.02 * jax.random.normal(ks[6], (DEPTH, D_MODEL), f32)
    w_gate_up = jax.random.normal(ks[7], (DEPTH, D_MODEL, 2 * FFN_HIDDEN), f32) * D_MODEL ** -0.5
    w_down = jax.random.normal(ks[8], (DEPTH, FFN_HIDDEN, D_MODEL), f32) * FFN_HIDDEN ** -0.5
    final_norm_w = 1.0 + 0.02 * jax.random.normal(ks[9], (D_MODEL,), f32)
    return {"x": x, "norm1_w": norm1_w, "w_in": w_in, "lb_logits": lb_logits,
            "hgrn_norm_w": hgrn_norm_w, "w_out": w_out, "norm2_w": norm2_w,
            "w_gate_up": w_gate_up, "w_down": w_down, "final_norm_w": final_norm_w}


def reference(x, norm1_w, w_in, lb_logits, hgrn_norm_w, w_out, norm2_w, w_gate_up, w_down, final_norm_w):
    lb_table = jnp.cumsum(jax.nn.softmax(lb_logits.astype(jnp.float32), axis=0), axis=0)
    h = x
    for l in range(DEPTH):
        u = rmsnorm(h, norm1_w[l])
        proj = jnp.einsum('bsd,de->bse', u, w_in[l])
        a = ATTN_WIDTH
        qa, ka, va = proj[..., :a], proj[..., a:2 * a], proj[..., 2 * a:3 * a]
        o = 3 * a
        w = HGRN_WIDTH
        qb, fb, ib, gb = (proj[..., o:o + w], proj[..., o + w:o + 2 * w],
                          proj[..., o + 2 * w:o + 3 * w], proj[..., o + 3 * w:o + 4 * w])
        ya = dilated_attention_group(qa, ka, va)
        yb = hgrn2_group(qb, fb, ib, gb, lb_table[l], hgrn_norm_w[l])
        mixed = jnp.concatenate([ya, yb], axis=-1).astype(h.dtype)
        h = h + jnp.einsum('bse,ed->bsd', mixed, w_out[l])
        u2 = rmsnorm(h, norm2_w[l])
        gu = jnp.einsum('bsd,df->bsf', u2, w_gate_up[l])
        gate, up = gu[..., :FFN_HIDDEN], gu[..., FFN_HIDDEN:]
        h = h + jnp.einsum('bsf,fd->bsd', jax.nn.silu(gate) * up, w_down[l])
    return rmsnorm(h, final_norm_w)
```

```cpp
#include <hip/hip_runtime.h>
#include <cstdio>
#include <cstdint>
constexpr int SEQ = 8192, DM = 1024, M = 2 * SEQ, NIN = 3584, FFH = 2816, NGU = 2 * FFH;
constexpr float EPS = 1e-6f;
constexpr int NWAVES = 8, NTHR = 512;
constexpr size_t MiB = 1u << 20;
constexpr size_t WS_SS1 = 0, WS_SS2 = 65536;
constexpr size_t WS_BAR = 131072;
constexpr size_t WS_ZERO_BYTES = 163840;
constexpr size_t WS_DTOT = 262144;
constexpr size_t WS_LB = 393216;
constexpr size_t WS_PCNT = 147456;
constexpr size_t WS_RSINV = 409600;
constexpr size_t WS_WIN = MiB / 2;
constexpr size_t WS_WOUT = WS_WIN + 7 * MiB;
constexpr size_t WS_WGU = WS_WOUT + 2 * MiB;
constexpr size_t WS_WDN = WS_WGU + 11 * MiB;
constexpr size_t WS_ROPE = WS_WDN + 11 * MiB / 2;
constexpr size_t WS_DEC = WS_ROPE + 2 * MiB;
constexpr size_t WS_LSE = WS_DEC + 2 * MiB;
static_assert(WS_LSE + 3 * MiB / 2 <= 32 * MiB, "region A");
constexpr size_t WS_XN = 32 * MiB;
constexpr size_t WS_OP0 = 32 * MiB, WS_OP1 = 48 * MiB;
constexpr size_t WS_MIX = 64 * MiB;
constexpr size_t WS_Q = 96 * MiB, WS_K = 112 * MiB, WS_V = 128 * MiB, WS_OP2 = 144 * MiB;
constexpr size_t WS_QI = 160 * MiB, WS_KX = 176 * MiB, WS_KUT = 192 * MiB, WS_VT = 208 * MiB, WS_GS = 224 * MiB, WS_U = 240 * MiB;
constexpr size_t WS_ACT = 160 * MiB;
constexpr size_t WS_END = 256 * MiB;
namespace pg8 {
#define PG8_LAS __attribute__((address_space(3)))
typedef unsigned short bf16_t;
typedef short bf16x8 __attribute__((ext_vector_type(8)));
typedef float f32x4 __attribute__((ext_vector_type(4)));
typedef unsigned u32x4 __attribute__((ext_vector_type(4))); typedef unsigned u32x2 __attribute__((ext_vector_type(2)));
constexpr int BM = 256, BK = 64, HALF = 128, HTB = HALF * BK * 2  , STAGE_BYTES = 8 * HTB, NXCD = 8, WGM = 8;

__host__ __device__ __forceinline__ int lds_byte(int r, int c) { const int st = (r >> 4) * 2 + (c >> 5), rr = r & 15, cc = c & 31, ob = rr * 64 + cc * 2; return st * 1024 + (ob ^ (((ob >> 9) & 1) << 5)); }
__host__ __device__ __forceinline__ void stage_rc(int b, int& R, int& C) { const int st = b / 1024, sb = b % 1024, swz = sb ^ (((sb >> 9) & 1) << 5); R = (st >> 1) * 16 + swz / 64; C = (st & 1) * 32 + (swz % 64) / 2; }
__host__ __device__ __forceinline__ int perm32(int rho) { const int n = rho >> 4, i = rho & 15; return 8 * (i >> 2) + 4 * n + (i & 3); }

struct Unit { int pm, pn; };
struct Gemm { const bf16_t* A; const bf16_t* Bt; int M, N, K; };

struct StaticOrder {
    int nM, nN, nwg, G, c;
    __host__ __device__ void init(int M, int N, int G_, int c_) { nM = M / BM; nN = N / BM; nwg = nM * nN; G = G_; c = c_; }
    __host__ __device__ bool next(int i, Unit& u) const {
        const long L = (long)i * G + c; if (L >= nwg) return false;
        int wgid = (int)L; { const int q = nwg / NXCD, r = nwg % NXCD, xcd = wgid % NXCD, off = wgid / NXCD; wgid = (xcd < r ? xcd * (q + 1) : r * (q + 1) + (xcd - r) * q) + off; }
        const int nig = WGM * nN, gid = wgid / nig, fm = gid * WGM, gsz = (nM - fm) < WGM ? (nM - fm) : WGM;
        u.pm = fm + ((wgid % nig) % gsz); u.pn = (wgid % nig) / gsz; return true;
    }
    __device__ __forceinline__ void a_ready(const Unit&) const {}
    __device__ __forceinline__ void done(const Unit&) const {}
};

__device__ __forceinline__ unsigned cvt_pk_bf16(float lo, float hi) { unsigned r; asm volatile("v_cvt_pk_bf16_f32 %0, %1, %2" : "=v"(r) : "v"(lo), "v"(hi)); return r; }
__device__ __forceinline__ unsigned short cvt_bf16(float x) { return (unsigned short)(cvt_pk_bf16(x, 0.f) & 0xffffu); }
__device__ __forceinline__ float sigmoidf_(float x) { return __builtin_amdgcn_rcpf(1.0f + __expf(-x)); }
__device__ __forceinline__ u32x4 pack8(const f32x4 a, const f32x4 b) { u32x4 w; w.x = cvt_pk_bf16(a[0], a[1]); w.y = cvt_pk_bf16(a[2], a[3]); w.z = cvt_pk_bf16(b[0], b[1]); w.w = cvt_pk_bf16(b[2], b[3]); return w; }

template <int CTRL> __device__ __forceinline__ float dpp1_f(float x) { return __int_as_float(__builtin_amdgcn_update_dpp(0x3f800000, __float_as_int(x), CTRL, 0xf, 0xf, false)); }
template <int CTRL> __device__ __forceinline__ float dpp_f(float x) { return __int_as_float(__builtin_amdgcn_update_dpp(0, __float_as_int(x), CTRL, 0xf, 0xf, true)); }
constexpr float QSCALE = 0.125f * 1.4426950408889634f;

struct EpiInProj {
    static constexpr bool PERM = true, AFTER_DRAIN = false;
    unsigned char* ws;
    __device__ __forceinline__ void operator()(const f32x4 (&acc)[2][2][4][2], const Unit& u, int wr, int wc, int fr, int fq) const {
        const int pn = u.pn; const int row0 = u.pm * BM + wr * 64 + fr;
        if (pn < 4) {
            const float* rope = (const float*)(ws + WS_ROPE);
            bf16_t* dst = (bf16_t*)(ws + ((pn < 2) ? WS_Q : WS_K)); const float sc = (pn < 2) ? QSCALE : 1.0f;
            const int col = 256 * (pn & 1) + 64 * wc + 8 * fq;
#pragma unroll
            for (int ai = 0; ai < 2; ++ai)
#pragma unroll
                for (int m = 0; m < 4; ++m) {
                    const int row = row0 + ai * HALF + m * 16; const int t = row & 8191;
                    const float* cp = rope + (size_t)t * 32 + 8 * fq; const float* sp = cp + 8192 * 32;
                    const f32x4 c0 = *(const f32x4*)cp, c1 = *(const f32x4*)(cp + 4), s0 = *(const f32x4*)sp, s1 = *(const f32x4*)(sp + 4);
                    const f32x4 a0 = acc[ai][0][m][0], a1 = acc[ai][0][m][1], b0 = acc[ai][1][m][0], b1 = acc[ai][1][m][1];
                    const f32x4 o10 = (a0 * c0 - b0 * s0) * sc, o11 = (a1 * c1 - b1 * s1) * sc, o20 = (b0 * c0 + a0 * s0) * sc, o21 = (b1 * c1 + a1 * s1) * sc;
                    bf16_t* rp = dst + (size_t)row * 512 + col;
                    *(u32x4*)rp = pack8(o10, o11); *(u32x4*)(rp + 32) = pack8(o20, o21);
                    asm volatile("" ::: "memory");
                }
        } else if (pn < 6) {
            bf16_t* V = (bf16_t*)(ws + WS_V);
            const int col = 256 * (pn - 4) + 32 * wc + 8 * fq;
#pragma unroll
            for (int ai = 0; ai < 2; ++ai)
#pragma unroll
                for (int m = 0; m < 4; ++m) {
                    const int row = row0 + ai * HALF + m * 16; bf16_t* rp = V + (size_t)row * 512 + col;
                    *(u32x4*)rp = pack8(acc[ai][0][m][0], acc[ai][0][m][1]); *(u32x4*)(rp + HALF) = pack8(acc[ai][1][m][0], acc[ai][1][m][1]);
                }
        } else {
            const int th = pn - 6; const int dbase = 64 * th + 16 * wc + 4 * fq;
            bf16_t* QI = (bf16_t*)(ws + WS_QI); bf16_t* KUT = (bf16_t*)(ws + WS_KUT); float* DEC = (float*)(ws + WS_DEC);
            bf16_t* VT = (bf16_t*)(ws + WS_VT); bf16_t* GS = (bf16_t*)(ws + WS_GS);
            const f32x4 lb4 = *(const f32x4*)((const float*)(ws + WS_LB) + dbase);
            constexpr float L2E = 1.4426950408889634f;
#pragma unroll
            for (int ai = 0; ai < 2; ++ai)
#pragma unroll
                for (int m = 0; m < 4; ++m) {
                    const int row = row0 + ai * HALF + m * 16; const unsigned chunk = (unsigned)row >> 4;
                    const unsigned ro = (unsigned)row * 512u + (unsigned)dbase, co = chunk * 512u + (unsigned)dbase, to = co * 16u + (unsigned)fr;
                    float qi[4], kx[4], dc[4];
#pragma unroll
                    for (int e = 0; e < 4; ++e) {
                        const float lbv = lb4[e], omlb = 1.0f - lbv;
                        const float qv = acc[ai][0][m][0][e], fv = acc[ai][1][m][0][e];
                        const float sg = __builtin_amdgcn_rcpf(1.0f + __builtin_amdgcn_exp2f(-L2E * fv)); const float f = lbv + omlb * sg; const float omf = omlb * (1.0f - sg);
                        float eb = f; eb *= dpp1_f<0x111>(eb); eb *= dpp1_f<0x112>(eb); eb *= dpp1_f<0x114>(eb); eb *= dpp1_f<0x118>(eb);
                        float ebl = f; ebl *= dpp1_f<0x128>(ebl); ebl *= dpp1_f<0x124>(ebl); ebl *= dpp1_f<0x122>(ebl); ebl *= dpp1_f<0x121>(ebl);
                        const float enb = __builtin_amdgcn_rcpf(eb);
                        const float sq = qv * __builtin_amdgcn_rcpf(1.0f + __builtin_amdgcn_exp2f(-L2E * qv));
                        qi[e] = sq * eb; kx[e] = omf * enb; dc[e] = ebl;
                        KUT[to + e * 16u] = cvt_bf16(kx[e] * ebl);
                        VT[to + e * 16u] = cvt_bf16(acc[ai][0][m][1][e]);
                    }
                    u32x2 w; w.x = cvt_pk_bf16(qi[0], qi[1]); w.y = cvt_pk_bf16(qi[2], qi[3]); *(u32x2*)(QI + ro) = w;
                    if (fr == 0) *(f32x4*)(DEC + co) = (f32x4){dc[0], dc[1], dc[2], dc[3]};
                    f32x4 gv = acc[ai][1][m][1];
#pragma unroll
                    for (int e = 0; e < 4; ++e) gv[e] = gv[e] * __builtin_amdgcn_rcpf(1.0f + __builtin_amdgcn_exp2f(-L2E * gv[e]));
                    w.x = cvt_pk_bf16(gv[0], gv[1]); w.y = cvt_pk_bf16(gv[2], gv[3]); *(u32x2*)(GS + ro) = w;
                    asm volatile("" ::: "memory");
                }
        }
    }
};

struct EpiOutProj {
    static constexpr bool PERM = true, AFTER_DRAIN = false;
    const float* X; bf16_t* HR; float* SS;
    __device__ __forceinline__ void operator()(const f32x4 (&acc)[2][2][4][2], const Unit& u, int wr, int wc, int fr, int fq) const {
        const int row0 = u.pm * BM + wr * 64 + fr; const int col0 = u.pn * BM + wc * 32 + 8 * fq;
        f32x4 xn[2][2];
        { const size_t off = (size_t)row0 * 1024 + col0;
#pragma unroll
          for (int bj = 0; bj < 2; ++bj) { xn[bj][0] = *(const f32x4*)(X + off + bj * HALF); xn[bj][1] = *(const f32x4*)(X + off + bj * HALF + 4); } }
#pragma unroll
        for (int i = 0; i < 8; ++i) {
            const int ai = i >> 2, m = i & 3;
            const int row = row0 + ai * HALF + m * 16; const size_t off = (size_t)row * 1024 + col0; float s = 0.f;
            f32x4 xc[2][2];
#pragma unroll
            for (int bj = 0; bj < 2; ++bj) { xc[bj][0] = xn[bj][0]; xc[bj][1] = xn[bj][1]; }
            if (i < 7) { const int rown = row0 + ((i + 1) >> 2) * HALF + ((i + 1) & 3) * 16; const size_t offn = (size_t)rown * 1024 + col0;
#pragma unroll
                for (int bj = 0; bj < 2; ++bj) { xn[bj][0] = *(const f32x4*)(X + offn + bj * HALF); xn[bj][1] = *(const f32x4*)(X + offn + bj * HALF + 4); } }
#pragma unroll
            for (int bj = 0; bj < 2; ++bj) {
                const f32x4 h0 = xc[bj][0] + acc[ai][bj][m][0], h1 = xc[bj][1] + acc[ai][bj][m][1];
                *(u32x4*)(HR + off + bj * HALF) = pack8(h0, h1);
                s += (h0[0] * h0[0] + h0[1] * h0[1]) + (h0[2] * h0[2] + h0[3] * h0[3]) + (h1[0] * h1[0] + h1[1] * h1[1]) + (h1[2] * h1[2] + h1[3] * h1[3]);
            }
            s += __shfl_xor(s, 16); s += __shfl_xor(s, 32);
            if (fq == 0) atomicAdd(SS + row, s);
            asm volatile("" ::: "memory");
        }
    }
};

struct EpiGateUp {
    static constexpr bool PERM = true, AFTER_DRAIN = false;
    bf16_t* ACT; const float* SS;
    __device__ __forceinline__ void operator()(const f32x4 (&acc)[2][2][4][2], const Unit& u, int wr, int wc, int fr, int fq) const {
        const int row0 = u.pm * BM + wr * 64 + fr; const int col0 = u.pn * HALF + wc * 32 + 8 * fq;
#pragma unroll
        for (int ai = 0; ai < 2; ++ai)
#pragma unroll
            for (int m = 0; m < 4; ++m) {
                const int row = row0 + ai * HALF + m * 16; const float rs = __builtin_amdgcn_rsqf(SS[row] * (1.0f / 1024.0f) + 1e-6f);
                f32x4 a0, a1;
#pragma unroll
                for (int e = 0; e < 4; ++e) { const float g0 = acc[ai][0][m][0][e] * rs, u0 = acc[ai][1][m][0][e] * rs, g1 = acc[ai][0][m][1][e] * rs, u1 = acc[ai][1][m][1][e] * rs;
                    a0[e] = g0 * sigmoidf_(g0) * u0; a1[e] = g1 * sigmoidf_(g1) * u1; }
                *(u32x4*)(ACT + (size_t)row * 2816 + col0) = pack8(a0, a1);
            }
    }
};

struct EpiDownNorm {
    static constexpr bool PERM = true, AFTER_DRAIN = true;
    const bf16_t* HR; float* OUT; float* SS; unsigned* cnt; const float* fw;
    __device__ __forceinline__ void fused(f32x4 (&acc)[2][2][4][2], const Unit& u, int wr, int wc, int fr, int fq, PG8_LAS unsigned char* lds, int wid, int lane) const {
        const int row0 = u.pm * BM + wr * 64 + fr; const int col0 = u.pn * BM + wc * 32 + 8 * fq;
        float olds[8] = {0.f, 0.f, 0.f, 0.f, 0.f, 0.f, 0.f, 0.f};
#pragma unroll
        for (int ai = 0; ai < 2; ++ai)
#pragma unroll
            for (int m = 0; m < 4; ++m) {
                const int row = row0 + ai * HALF + m * 16; const unsigned off = (unsigned)row * 1024u + (unsigned)col0; float s = 0.f;
#pragma unroll
                for (int bj = 0; bj < 2; ++bj) {
                    const u32x4 hr = *(const u32x4*)(HR + off + bj * HALF);
                    const f32x4 r0 = (f32x4){__uint_as_float(hr.x << 16), __uint_as_float(hr.x & 0xffff0000u), __uint_as_float(hr.y << 16), __uint_as_float(hr.y & 0xffff0000u)};
                    const f32x4 r1 = (f32x4){__uint_as_float(hr.z << 16), __uint_as_float(hr.z & 0xffff0000u), __uint_as_float(hr.w << 16), __uint_as_float(hr.w & 0xffff0000u)};
                    const f32x4 h0 = r0 + acc[ai][bj][m][0], h1 = r1 + acc[ai][bj][m][1];
                    acc[ai][bj][m][0] = h0; acc[ai][bj][m][1] = h1;
                    s += (h0[0] * h0[0] + h0[1] * h0[1]) + (h0[2] * h0[2] + h0[3] * h0[3]) + (h1[0] * h1[0] + h1[1] * h1[1]) + (h1[2] * h1[2] + h1[3] * h1[3]);
                }
                s += __shfl_xor(s, 16); s += __shfl_xor(s, 32);
                if (fq == 0) olds[ai * 4 + m] = atomicAdd(SS + row, s);
            }
#pragma unroll
        for (int i = 0; i < 8; ++i) asm volatile("" :: "v"(olds[i]));
        asm volatile("s_waitcnt vmcnt(0)" ::: "memory");
        __syncthreads();
        if (wid == 0 && lane == 0) {
            __hip_atomic_fetch_add(cnt + 64 * u.pm, 1u, __ATOMIC_RELAXED, __HIP_MEMORY_SCOPE_AGENT);
            unsigned sp = 0;
            while (__hip_atomic_load(cnt + 64 * u.pm, __ATOMIC_RELAXED, __HIP_MEMORY_SCOPE_AGENT) < 4u) { __builtin_amdgcn_s_sleep(1); if (++sp > (1u << 22)) break; }
        }
        __syncthreads();
        f32x4 w[2][2];
#pragma unroll
        for (int bj = 0; bj < 2; ++bj)
#pragma unroll
            for (int n = 0; n < 2; ++n) w[bj][n] = *(const f32x4*)(fw + col0 + bj * HALF + 4 * n);
        float tots[8];
#pragma unroll
        for (int i = 0; i < 8; ++i) { tots[i] = 0.f; if (fq == 0) tots[i] = atomicAdd(SS + row0 + (i >> 2) * HALF + (i & 3) * 16, 0.0f); }
#pragma unroll
        for (int ai = 0; ai < 2; ++ai)
#pragma unroll
            for (int m = 0; m < 4; ++m) {
                const int row = row0 + ai * HALF + m * 16; const unsigned off = (unsigned)row * 1024u + (unsigned)col0;
                const float tot = __shfl(tots[ai * 4 + m], fr, 64);
                const float rs = __builtin_amdgcn_rsqf(tot * (1.0f / 1024.0f) + 1e-6f);
#pragma unroll
                for (int bj = 0; bj < 2; ++bj) {
                    *(f32x4*)(OUT + off + bj * HALF) = acc[ai][bj][m][0] * rs * w[bj][0]; *(f32x4*)(OUT + off + bj * HALF + 4) = acc[ai][bj][m][1] * rs * w[bj][1];
                }
                asm volatile("" ::: "memory");
            }
    }
};

template <class Epi, class Sched, bool ALIGN_EPI = false, bool SP2 = false>
__device__ __forceinline__ void gemm_phase(PG8_LAS unsigned char* lds, const Gemm g, const Sched& S, const Epi& E) {
    int tid_ = threadIdx.x; asm volatile("" : "+v"(tid_));
    const int tid = tid_, wid = __builtin_amdgcn_readfirstlane(tid >> 6), lane = tid & 63, wr = wid >> 2, wc = wid & 3, fr = lane & 15, fq = lane >> 4;
    const int K = g.K, nt = K / BK;
    unsigned voffA[2], voffB[2];
#pragma unroll
    for (int i = 0; i < 2; ++i) { int R, C; stage_rc(tid * 16 + i * 8192, R, C); const int Rb = Epi::PERM ? ((R & ~31) + perm32(R & 31)) : R;
        voffA[i] = (unsigned)(R * K + C) * 2u; voffB[i] = (unsigned)(Rb * K + C) * 2u; }
    const size_t kstep = (size_t)(BK * 2);
    const size_t hstep = (size_t)HALF * K * 2;
    const size_t tstep = 2 * hstep;
    const unsigned ldsw = (unsigned)wid * 1024u;
    const int aoff = lds_byte(wr * 64 + fr, fq * 8), boff = lds_byte(wc * 32 + fr, fq * 8);
#define PG8_SA(b, h) (((b) * 2 + (h)) * HTB)
#define PG8_SB(b, h) ((4 + (b) * 2 + (h)) * HTB)
#define PG8_STAGE(bufoff, gbase, voff) do { _Pragma("unroll") for (int _i = 0; _i < 2; ++_i) \
        __builtin_amdgcn_global_load_lds((const unsigned*)((const char*)(gbase) + (voff)[_i]), (PG8_LAS unsigned*)(lds + (bufoff) + ldsw + _i * 8192), 16, 0, 0); } while (0)
#define PG8_LDA(dst, b, h) do { _Pragma("unroll") for (int m = 0; m < 4; ++m) _Pragma("unroll") for (int k = 0; k < 2; ++k) dst[m][k] = *(const PG8_LAS bf16x8*)(lds + PG8_SA(b, h) + aoff + m * 2048 + k * 1024); } while (0)
#define PG8_LDB(dst, b, h) do { _Pragma("unroll") for (int n = 0; n < 2; ++n) _Pragma("unroll") for (int k = 0; k < 2; ++k) dst[n][k] = *(const PG8_LAS bf16x8*)(lds + PG8_SB(b, h) + boff + n * 2048 + k * 1024); } while (0)
#define PG8_MMA(ai, bj, At, Bt) do { __builtin_amdgcn_s_setprio(1); _Pragma("unroll") for (int m = 0; m < 4; ++m) _Pragma("unroll") for (int n = 0; n < 2; ++n) _Pragma("unroll") for (int k = 0; k < 2; ++k) \
        acc[ai][bj][m][n] = __builtin_amdgcn_mfma_f32_16x16x32_bf16(Bt[n][k], At[m][k], acc[ai][bj][m][n], 0, 0, 0); __builtin_amdgcn_s_setprio(0); } while (0)
#define PG8_WAIT_V(n) asm volatile("s_waitcnt vmcnt(" #n ")" ::: "memory")
#define PG8_WAIT_L(n) asm volatile("s_waitcnt lgkmcnt(" #n ")" ::: "memory")
#define PG8_BAR __builtin_amdgcn_s_barrier()
#define PG8_SCHED __builtin_amdgcn_sched_barrier(0)
    Unit cur, nxt; int ui = 0;
    if (!S.next(0, cur)) return;
    f32x4 acc[2][2][4][2];
#pragma unroll
    for (int a = 0; a < 2; ++a)
#pragma unroll
        for (int b = 0; b < 2; ++b)
#pragma unroll
            for (int m = 0; m < 4; ++m)
#pragma unroll
                for (int n = 0; n < 2; ++n) acc[a][b][m][n] = (f32x4){0.f, 0.f, 0.f, 0.f};
    bf16x8 At[4][2], B0[2][2], B1[2][2];
    const char* cA = (const char*)g.A + (size_t)cur.pm * tstep; const char* cB = (const char*)g.Bt + (size_t)cur.pn * tstep;
    S.a_ready(cur);
    if constexpr (SP2) {
        PG8_STAGE(PG8_SB(0, 0), cB, voffB); PG8_STAGE(PG8_SB(0, 1), cB + hstep, voffB); PG8_STAGE(PG8_SA(0, 0), cA, voffA); PG8_STAGE(PG8_SA(0, 1), cA + hstep, voffA);
        if (wr == 1) PG8_BAR;
        PG8_WAIT_V(2); PG8_BAR;
        PG8_STAGE(PG8_SB(1, 0), cB + kstep, voffB); PG8_STAGE(PG8_SA(1, 0), cA + kstep, voffA); PG8_STAGE(PG8_SB(1, 1), cB + hstep + kstep, voffB);
        PG8_WAIT_V(6); PG8_BAR;
    } else {
        PG8_STAGE(PG8_SB(0, 0), cB, voffB); PG8_STAGE(PG8_SA(0, 0), cA, voffA); PG8_STAGE(PG8_SB(0, 1), cB + hstep, voffB); PG8_STAGE(PG8_SA(0, 1), cA + hstep, voffA);
        if (wr == 1) PG8_BAR;
        PG8_WAIT_V(4); PG8_BAR;
        PG8_STAGE(PG8_SB(1, 0), cB + kstep, voffB); PG8_STAGE(PG8_SA(1, 0), cA + kstep, voffA); PG8_STAGE(PG8_SB(1, 1), cB + hstep + kstep, voffB);
        PG8_WAIT_V(6); PG8_BAR;
    }
    for (;;) {
        const bool has_next = S.next(ui + 1, nxt);
        const char* nA = has_next ? (const char*)g.A + (size_t)nxt.pm * tstep : cA; const char* nB = has_next ? (const char*)g.Bt + (size_t)nxt.pn * tstep : cB;
        for (int t = 0; t < nt; t += 2) {
            const bool last = (t == nt - 2);
            const char* a1 = cA + (size_t)(t + 1) * kstep;
            const char* a2 = last ? nA : cA + (size_t)(t + 2) * kstep; const char* b2 = last ? nB : cB + (size_t)(t + 2) * kstep;
            const char* a3 = a2 + kstep; const char* b3 = b2 + kstep;
            if (last && has_next) S.a_ready(nxt);
            if constexpr (SP2) {
            PG8_LDB(B0, 0, 0); PG8_LDB(B1, 0, 1); PG8_SCHED; PG8_LDA(At, 0, 0); PG8_STAGE(PG8_SA(1, 1), a1 + hstep, voffA);
            PG8_WAIT_V(8); PG8_WAIT_L(0); PG8_BAR; PG8_MMA(0, 0, At, B0); PG8_MMA(0, 1, At, B1); PG8_BAR; PG8_SCHED;
            PG8_LDA(At, 0, 1); PG8_STAGE(PG8_SB(0, 0), b2, voffB); PG8_STAGE(PG8_SB(0, 1), b2 + hstep, voffB); PG8_STAGE(PG8_SA(0, 0), a2, voffA);
            PG8_WAIT_V(8); PG8_WAIT_L(0); PG8_BAR; PG8_MMA(1, 0, At, B0); PG8_MMA(1, 1, At, B1); PG8_BAR; PG8_SCHED;
            PG8_LDB(B0, 1, 0); PG8_LDB(B1, 1, 1); PG8_SCHED; PG8_LDA(At, 1, 0); PG8_STAGE(PG8_SA(0, 1), a2 + hstep, voffA);
            PG8_WAIT_V(8); PG8_WAIT_L(0); PG8_BAR; PG8_MMA(0, 0, At, B0); PG8_MMA(0, 1, At, B1); PG8_BAR; PG8_SCHED;
            PG8_LDA(At, 1, 1); PG8_STAGE(PG8_SB(1, 0), b3, voffB); PG8_STAGE(PG8_SB(1, 1), b3 + hstep, voffB); PG8_STAGE(PG8_SA(1, 0), a3, voffA);
            PG8_WAIT_V(8); PG8_WAIT_L(0); PG8_BAR; PG8_MMA(1, 0, At, B0); PG8_MMA(1, 1, At, B1); PG8_BAR; PG8_SCHED;
            } else {
            PG8_LDB(B0, 0, 0); PG8_SCHED; PG8_LDA(At, 0, 0); PG8_STAGE(PG8_SA(1, 1), a1 + hstep, voffA);
            PG8_WAIT_L(8); PG8_BAR; PG8_WAIT_L(0); PG8_MMA(0, 0, At, B0); PG8_BAR; PG8_SCHED;
            PG8_LDB(B1, 0, 1); PG8_STAGE(PG8_SB(0, 0), b2, voffB);
            PG8_BAR; PG8_WAIT_L(0); PG8_MMA(0, 1, At, B1); PG8_BAR;
            PG8_LDA(At, 0, 1); PG8_STAGE(PG8_SA(0, 0), a2, voffA);
            PG8_BAR; PG8_WAIT_L(0); PG8_MMA(1, 0, At, B0); PG8_BAR; PG8_SCHED;
            PG8_STAGE(PG8_SB(0, 1), b2 + hstep, voffB);
            PG8_WAIT_V(6); PG8_BAR; PG8_MMA(1, 1, At, B1); PG8_BAR;
            PG8_LDB(B0, 1, 0); PG8_SCHED; PG8_LDA(At, 1, 0); PG8_STAGE(PG8_SA(0, 1), a2 + hstep, voffA);
            PG8_WAIT_L(8); PG8_BAR; PG8_WAIT_L(0); PG8_MMA(0, 0, At, B0); PG8_BAR; PG8_SCHED;
            PG8_LDB(B1, 1, 1); PG8_STAGE(PG8_SB(1, 0), b3, voffB);
            PG8_BAR; PG8_WAIT_L(0); PG8_MMA(0, 1, At, B1); PG8_BAR;
            PG8_LDA(At, 1, 1); PG8_STAGE(PG8_SA(1, 0), a3, voffA);
            PG8_BAR; PG8_WAIT_L(0); PG8_MMA(1, 0, At, B0); PG8_BAR; PG8_SCHED;
            PG8_STAGE(PG8_SB(1, 1), b3 + hstep, voffB);
            PG8_WAIT_V(6); PG8_BAR; PG8_MMA(1, 1, At, B1); PG8_BAR;
            }
        }
        if constexpr (ALIGN_EPI) { if (wr == 0) PG8_BAR; }
        if constexpr (!Epi::AFTER_DRAIN) { E(acc, cur, wr, wc, fr, fq); S.done(cur); }
        if (!has_next) break;
#pragma unroll
        for (int a = 0; a < 2; ++a)
#pragma unroll
            for (int b = 0; b < 2; ++b)
#pragma unroll
                for (int m = 0; m < 4; ++m)
#pragma unroll
                    for (int n = 0; n < 2; ++n) acc[a][b][m][n] = (f32x4){0.f, 0.f, 0.f, 0.f};
        cur = nxt; cA = nA; cB = nB; ++ui;
        if constexpr (ALIGN_EPI) { if (wr == 1) PG8_BAR; }
    }
    PG8_WAIT_V(0);
    if constexpr (!ALIGN_EPI) { if (wr == 0) PG8_BAR; }
    PG8_BAR;
    if constexpr (Epi::AFTER_DRAIN) { E.fused(acc, cur, wr, wc, fr, fq, lds, wid, lane); S.done(cur); }
#undef PG8_SA
#undef PG8_SB
#undef PG8_STAGE
#undef PG8_LDA
#undef PG8_LDB
#undef PG8_MMA
#undef PG8_WAIT_V
#undef PG8_WAIT_L
#undef PG8_BAR
#undef PG8_SCHED
}
}

constexpr int RING_BYTES = 131072, LDS_BYTES = 147456;

#define GAS __attribute__((address_space(1)))
#define LAS __attribute__((address_space(3)))
typedef unsigned short bf16;
typedef float f32x4 __attribute__((ext_vector_type(4)));
typedef float f32x16 __attribute__((ext_vector_type(16)));
typedef short bf16x8 __attribute__((ext_vector_type(8)));
typedef short s16x4 __attribute__((ext_vector_type(4)));
typedef unsigned u32x4 __attribute__((ext_vector_type(4)));
typedef unsigned u32x2 __attribute__((ext_vector_type(2)));
using pg8::cvt_pk_bf16; using pg8::cvt_bf16;

__device__ __forceinline__ float bf2f(unsigned short h) { return __uint_as_float(((unsigned)h) << 16); }

__device__ __forceinline__ int bt_row_inproj(int c) {
    if (c < 1024) { const int region = c >> 9, cc = c & 511; const int tr = cc >> 8, hl = (cc >> 6) & 3, half = (cc >> 5) & 1, idx = cc & 31; return 256 * (2 * region + tr) + 128 * half + 32 * hl + idx; }
    if (c < 1536) return c;
    const int cc = c - 1536; const int arr = cc >> 9, d = cc & 511; const int th = d >> 6, dd = d & 63;
    return 256 * (6 + th) + 128 * (arr & 1) + 32 * (dd >> 4) + 8 * ((dd >> 2) & 3) + 4 * (arr >> 1) + (dd & 3);
}
__device__ __forceinline__ int bt_row_gu(int c) { if (c < FFH) return 256 * (c >> 7) + (c & 127); const int j = c - FFH; return 256 * (j >> 7) + 128 + (j & 127); }

template <int MAP> __device__ __forceinline__ void p0_transpose_item(const float* W, int K, int N, bf16* WT, LAS float* scr, int item, int lane, const float* kscale = nullptr) {
    const int nblk = N / 32, kb = item / nblk, nb = item % nblk, k0 = 64 * kb, n0 = 32 * nb;
#pragma unroll 8
    for (int i = 0; i < 32; ++i) { const int kk = 2 * i + (lane >> 5); scr[kk * 33 + (lane & 31)] = W[(size_t)(k0 + kk) * N + n0 + (lane & 31)]; }
    asm volatile("s_waitcnt lgkmcnt(0)" ::: "memory");
    const int c = lane & 7;
    f32x4 ks0 = (f32x4){1.f, 1.f, 1.f, 1.f}, ks1 = ks0;
    if (kscale) { ks0 = *(const f32x4*)(kscale + k0 + 8 * c); ks1 = *(const f32x4*)(kscale + k0 + 8 * c + 4); }
#pragma unroll
    for (int j = 0; j < 4; ++j) { const int n = (lane >> 3) + 8 * j; const LAS float* s = scr + (8 * c) * 33 + n;
        u32x4 o; o.x = cvt_pk_bf16(s[0 * 33] * ks0[0], s[1 * 33] * ks0[1]); o.y = cvt_pk_bf16(s[2 * 33] * ks0[2], s[3 * 33] * ks0[3]); o.z = cvt_pk_bf16(s[4 * 33] * ks1[0], s[5 * 33] * ks1[1]); o.w = cvt_pk_bf16(s[6 * 33] * ks1[2], s[7 * 33] * ks1[3]);
        const int rr = (MAP == 1) ? bt_row_inproj(n0 + n) : (MAP == 2) ? bt_row_gu(n0 + n) : n0 + n;
        *(u32x4*)(WT + (size_t)rr * K + k0 + 8 * c) = o; }
    asm volatile("s_waitcnt lgkmcnt(0)" ::: "memory");
}
__device__ __forceinline__ float wave_sum(float v) {
#pragma unroll
    for (int o = 1; o < 64; o <<= 1) v += __shfl_xor(v, o);
    return v;
}

#define RLX_AGENT __ATOMIC_RELAXED, __HIP_MEMORY_SCOPE_AGENT
#define XB_TMO      128
#define XB_XCNT(j)  (256  + 64 * (j))
#define XB_XSUB(j)  (1280 + 64 * (j))
#define XB_XGEN(j)  (2304 + 64 * (j))
#define XB_TOP      3328
#define XB_TOPGEN   3392
#define XCD_BAR_WORDS 3456
#define XB_SPIN_CAP (1u << 18)

__device__ __forceinline__ unsigned xb_ld(unsigned* p)              { return __hip_atomic_load(p, __ATOMIC_RELAXED, __HIP_MEMORY_SCOPE_AGENT); }
__device__ __forceinline__ unsigned xb_add(unsigned* p, unsigned v) { return __hip_atomic_fetch_add(p, v, __ATOMIC_RELAXED, __HIP_MEMORY_SCOPE_AGENT); }
__device__ __forceinline__ unsigned xb_xcc_id() { return (unsigned)__builtin_amdgcn_s_getreg((3 << 11) | 20) & 0xFu; }
#define XB_SPIN(cond, bar) do { unsigned _sp = 0; while (cond) { __builtin_amdgcn_s_sleep(1); \
    if ((++_sp & 255u) == 0u) { if (xb_ld(&(bar)[XB_TMO])) break; if (_sp > XB_SPIN_CAP) { atomicAdd(&(bar)[XB_TMO], 1u); break; } } } } while (0)

struct XcdBarrier {
    unsigned* bar; unsigned x;
    volatile LAS unsigned* st;
};

__device__ __forceinline__ XcdBarrier xcd_barrier_post(unsigned* bar, volatile LAS unsigned* st) {
    XcdBarrier b; b.bar = bar; b.x = xb_xcc_id(); b.st = st;
    if (threadIdx.x == 0) (void)xb_add(&bar[XB_XCNT(b.x)], 1u);
    return b;
}
__device__ __forceinline__ void xcd_barrier_complete(unsigned* bar, unsigned x, unsigned& nloc, unsigned& nx) {
    const unsigned G = gridDim.x * gridDim.y * gridDim.z;
    unsigned sum, cnt, mine, sp = 0u;
    for (;;) {
        sum = 0u; cnt = 0u; mine = 0u;
#pragma unroll
        for (unsigned j = 0; j < 16; ++j) { const unsigned c = xb_ld(&bar[XB_XCNT(j)]); sum += c; cnt += (c > 0u) ? 1u : 0u; mine = (j == x) ? c : mine; }
        if (sum == G) break;
        __builtin_amdgcn_s_sleep(1);
        if ((++sp & 255u) == 0u) { if (xb_ld(&bar[XB_TMO])) break; if (sp > XB_SPIN_CAP) { atomicAdd(&bar[XB_TMO], 1u); break; } }
    }
    nloc = mine > 0u ? mine : 1u; nx = cnt > 0u ? cnt : 1u;
}

__device__ __forceinline__ void xcd_barrier(const XcdBarrier& b) {
    asm volatile("s_waitcnt vmcnt(0)" ::: "memory");
    __syncthreads();
    if (threadIdx.x == 0) {
        unsigned* bar = b.bar;
        __builtin_amdgcn_s_waitcnt(0);
        unsigned nloc = b.st[0], nx = b.st[1];
        if (nloc == 0u) { xcd_barrier_complete(bar, b.x, nloc, nx); b.st[0] = nloc; b.st[1] = nx; }
        const unsigned old = xb_add(&bar[XB_XSUB(b.x)], 1u);
        const unsigned gen = old / nloc;
        if (old + 1u == (gen + 1u) * nloc) {
            __builtin_amdgcn_fence(__ATOMIC_RELEASE, "agent");
            asm volatile("s_waitcnt vmcnt(0)" ::: "memory");
            const unsigned og = xb_add(&bar[XB_TOP], 1u);
            const unsigned tg = og / nx;
            if (og + 1u == (tg + 1u) * nx) xb_add(&bar[XB_TOPGEN], 1u);
            else XB_SPIN(xb_ld(&bar[XB_TOPGEN]) == tg, bar);
            __builtin_amdgcn_fence(__ATOMIC_ACQUIRE, "agent");
            xb_add(&bar[XB_XGEN(b.x)], 1u);
            asm volatile("s_waitcnt vmcnt(0)" ::: "memory");
        } else {
            XB_SPIN(xb_ld(&bar[XB_XGEN(b.x)]) == gen, bar);
            __builtin_amdgcn_fence(__ATOMIC_ACQUIRE, "agent");
            asm volatile("s_waitcnt vmcnt(0)" ::: "memory");
        }
    }
    __syncthreads();
}

struct Args { const float* in[10]; float* out; unsigned char* ws; };
__device__ __forceinline__ void prefetch_lines(const unsigned char* p, int nlines, int gt, int NGT) {
    for (int i = gt; i < nlines; i += NGT) { const unsigned v = *(const unsigned*)(p + (size_t)i * 128); asm volatile("" :: "v"(v)); }
}

__device__ __forceinline__ void p0_prologue(const Args& a, LAS unsigned char* lds, int gw, int NGW, int wave, int lane) {
    unsigned char* ws = a.ws;
    LAS float* scr = (LAS float*)(lds + wave * 16384);
    constexpr int I_IN = (DM / 64) * (NIN / 32);
    for (int it = gw; it < I_IN; it += NGW) p0_transpose_item<1>(a.in[2], DM, NIN, (bf16*)(ws + WS_WIN), scr, it, lane);
    const float* x = a.in[0]; const float* n1 = a.in[1]; bf16* XN = (bf16*)(ws + WS_XN);
    f32x4 nwv[4];
#pragma unroll
    for (int j = 0; j < 4; ++j) nwv[j] = *((const f32x4*)n1 + lane + 64 * j);
    for (int mi = gw; mi < M; mi += NGW) {
        const int m = (NGW == 2048) ? (2048 * ((mi >> 3) & 7) + 64 * ((mi >> 6) & 31) + 8 * (mi & 7) + (mi >> 11)) : mi;
        const f32x4* xr = (const f32x4*)(x + (size_t)m * DM) + lane; f32x4 v[4]; float s = 0.f;
#pragma unroll
        for (int j = 0; j < 4; ++j) { v[j] = xr[64 * j]; s += (v[j].x * v[j].x + v[j].y * v[j].y) + (v[j].z * v[j].z + v[j].w * v[j].w); }
        const float rs = 1.0f / sqrtf(wave_sum(s) * (1.0f / DM) + EPS);
        u32x2* o8 = (u32x2*)(XN + (size_t)m * DM) + lane;
#pragma unroll
        for (int j = 0; j < 4; ++j) { const f32x4 y = v[j] * rs * nwv[j]; u32x2 w; w.x = cvt_pk_bf16(y.x, y.y); w.y = cvt_pk_bf16(y.z, y.w); o8[64 * j] = w; }
    }
    if (gw == 0) { const float* ll = a.in[3]; float* lbt = (float*)(ws + WS_LB); for (int i = lane; i < 512; i += 64) lbt[i] = 1.0f / (1.0f + expf(ll[512 + i] - ll[i])); }
    const int gt = gw * 64 + lane, NGT = NGW * 64;
    float* rope = (float*)(ws + WS_ROPE);
    for (int i = gt; i < SEQ * 32; i += NGT) { const int t = i >> 5, k = i & 31; const float inv = powf(10000.0f, -(float)k / 32.0f); const float ang = (float)t * inv;
        rope[i] = cosf(ang); rope[SEQ * 32 + i] = sinf(ang); }
}

__device__ __forceinline__ void convert_rest(const Args& a, LAS unsigned char* lds, int gw2, int NGW2, int wave, int lane) {
    unsigned char* ws = a.ws;
    LAS float* scr = (LAS float*)(lds + wave * 16384);
    constexpr int I_OUT = (DM / 64) * (DM / 32), I_GU = (DM / 64) * (NGU / 32), I_DN = (FFH / 64) * (DM / 32);
    for (int it = gw2; it < I_OUT + I_GU + I_DN; it += NGW2) {
        int r = it;
        if (r < I_OUT) { p0_transpose_item<0>(a.in[5], DM, DM, (bf16*)(ws + WS_WOUT), scr, r, lane); continue; } r -= I_OUT;
        if (r < I_GU) { p0_transpose_item<2>(a.in[7], DM, NGU, (bf16*)(ws + WS_WGU), scr, r, lane, a.in[6]); continue; } r -= I_GU;
        p0_transpose_item<0>(a.in[8], FFH, DM, (bf16*)(ws + WS_WDN), scr, r, lane);
    }
}

constexpr int KPITCH = 144, KROWS = 384, VOFF = KROWS * KPITCH;
__device__ __forceinline__ int crow(int r, int hi) { return (r & 3) + 8 * (r >> 2) + 4 * hi; }
__device__ __forceinline__ s16x4 vtr(const LAS unsigned char* p) { typedef short v4i16_t __attribute__((ext_vector_type(4))); return __builtin_bit_cast(s16x4, __builtin_amdgcn_ds_read_tr16_b64_v4i16((LAS v4i16_t*)p)); }

struct AttnU { int pat, b, h, r, m0, dsh; };
__device__ __forceinline__ AttnU attn_decode(int unit) {
    AttnU U; U.pat = unit >> 9; const int rem = unit & 511, bh = rem >> 5, blk = rem & 31; U.b = bh >> 3; U.h = bh & 7;
    U.dsh = 2 * U.pat;
    const int bps = 32 >> U.dsh;
    U.r = blk / bps; U.m0 = 256 * (blk % bps); return U;
}
__device__ __forceinline__ void attn_load(const AttnU& U, unsigned char* ws, int tid, int wave, int lane, u32x4 (&kr)[6], u32x4 (&vr)[6], bf16x8 (&qf)[4]) {
    const bf16* Qg = (const bf16*)(ws + WS_Q) + (size_t)U.b * SEQ * 512 + U.h * 64;
    const bf16* Kg = (const bf16*)(ws + WS_K) + (size_t)U.b * SEQ * 512 + U.h * 64;
    const bf16* Vg = (const bf16*)(ws + WS_V) + (size_t)U.b * SEQ * 512 + U.h * 64;
#pragma unroll
    for (int it = 0; it < 6; ++it) {
        const int i = tid + it * NTHR; const int row = i >> 3, ch = i & 7; const int mk = U.m0 - 128 + row;
        kr[it] = (u32x4){0u, 0u, 0u, 0u}; vr[it] = (u32x4){0u, 0u, 0u, 0u};
        if (mk >= 0) { const unsigned off = (unsigned)((mk << U.dsh) + U.r) * 512u + (unsigned)(ch * 8); kr[it] = *(const u32x4*)(Kg + off); vr[it] = *(const u32x4*)(Vg + off); }
    }
    const int ql = lane & 31, hi = lane >> 5; const int mq = U.m0 + 32 * wave + ql; const unsigned tq = (unsigned)((mq << U.dsh) + U.r);
#pragma unroll
    for (int kk = 0; kk < 4; ++kk) qf[kk] = *(const bf16x8*)(Qg + tq * 512u + (unsigned)(16 * kk + 8 * hi));
}
__device__ __forceinline__ void attn_stage(LAS unsigned char* lds, int tid, const u32x4 (&kr)[6], const u32x4 (&vr)[6]) {
#pragma unroll
    for (int it = 0; it < 6; ++it) { const int i = tid + it * NTHR; const int row = i >> 3, ch = i & 7;
        *(LAS u32x4*)(lds + row * KPITCH + ch * 16) = kr[it]; *(LAS u32x4*)(lds + VOFF + row * KPITCH + ch * 16) = vr[it]; }
}
__device__ __forceinline__ void attn_compute(const AttnU& U, LAS unsigned char* lds, unsigned char* ws, int wave, int lane, const bf16x8 (&qf)[4]) {
    const int pat = U.pat, m0 = U.m0, dsh = U.dsh, r = U.r;
    bf16* Og = (bf16*)(ws + (pat == 0 ? WS_OP0 : pat == 1 ? WS_OP1 : WS_OP2)) + (size_t)U.b * SEQ * 512 + U.h * 64;
    float* Lg = (float*)(ws + WS_LSE) + ((size_t)(pat * 16 + U.b * 8 + U.h) * SEQ + (size_t)r * (SEQ >> dsh));
    const int ql = lane & 31, hi = lane >> 5;
    const int mq = m0 + 32 * wave + ql; const size_t tq = (size_t)((mq << dsh) + r);
    f32x16 st[5];
#pragma unroll
    for (int kt = 0; kt < 5; ++kt) {
        st[kt] = (f32x16){};
        const LAS unsigned char* kp = lds + (32 * wave + 32 * kt + ql) * KPITCH + 16 * hi;
#pragma unroll
        for (int kk = 0; kk < 4; ++kk) { const bf16x8 kf = *(const LAS bf16x8*)(kp + 32 * kk); st[kt] = __builtin_amdgcn_mfma_f32_32x32x16_bf16(kf, qf[kk], st[kt], 0, 0, 0); }
    }
    const float NEG = -1e30f; float mx = NEG;
#pragma unroll
    for (int kt = 0; kt < 5; ++kt)
#pragma unroll
        for (int i = 0; i < 16; ++i) {
            const int cr = crow(i, hi); const int R = 32 * wave + 32 * kt + cr;
            bool ok = (m0 - 128 + R) >= 0;
            if (kt == 0) ok = ok && (cr >= ql);
            if (kt == 4) ok = ok && (cr <= ql);
            const float s = ok ? st[kt][i] : NEG; st[kt][i] = s; mx = fmaxf(mx, s);
        }
    mx = fmaxf(mx, __shfl_xor(mx, 32));
    float lsum = 0.f;
#pragma unroll
    for (int kt = 0; kt < 5; ++kt)
#pragma unroll
        for (int i = 0; i < 16; ++i) { const float p = __builtin_amdgcn_exp2f(st[kt][i] - mx); st[kt][i] = p; lsum += p; }
    lsum += __shfl_xor(lsum, 32);
    f32x16 o[2]; o[0] = (f32x16){}; o[1] = (f32x16){};
    const int blk16 = (lane >> 4) & 1, q4 = (lane & 15) >> 2, p4 = lane & 3;
    const LAS unsigned char* vbase = lds + VOFF + (32 * wave + 4 * hi + q4) * KPITCH + (16 * blk16 + 4 * p4) * 2;
#pragma unroll
    for (int kt = 0; kt < 5; ++kt)
#pragma unroll
        for (int ks = 0; ks < 2; ++ks) {
            u32x4 pw; pw.x = cvt_pk_bf16(st[kt][8 * ks + 0], st[kt][8 * ks + 1]); pw.y = cvt_pk_bf16(st[kt][8 * ks + 2], st[kt][8 * ks + 3]);
            pw.z = cvt_pk_bf16(st[kt][8 * ks + 4], st[kt][8 * ks + 5]); pw.w = cvt_pk_bf16(st[kt][8 * ks + 6], st[kt][8 * ks + 7]);
            const bf16x8 pb = __builtin_bit_cast(bf16x8, pw);
#pragma unroll
            for (int c = 0; c < 2; ++c) {
                const LAS unsigned char* vp = vbase + (32 * kt + 16 * ks) * KPITCH + 64 * c;
                const s16x4 v0 = vtr(vp), v1 = vtr(vp + 8 * KPITCH);
                const bf16x8 va = (bf16x8){v0[0], v0[1], v0[2], v0[3], v1[0], v1[1], v1[2], v1[3]};
                o[c] = __builtin_amdgcn_mfma_f32_32x32x16_bf16(va, pb, o[c], 0, 0, 0);
            }
        }
    const float rl = 1.0f / lsum;
    bf16* orow = Og + tq * 512;
#pragma unroll
    for (int c = 0; c < 2; ++c)
#pragma unroll
        for (int g = 0; g < 4; ++g) { u32x2 w; w.x = cvt_pk_bf16(o[c][4 * g] * rl, o[c][4 * g + 1] * rl); w.y = cvt_pk_bf16(o[c][4 * g + 2] * rl, o[c][4 * g + 3] * rl);
            *(u32x2*)(orow + 32 * c + 8 * g + 4 * hi) = w; }
    if (hi == 0) Lg[mq] = mx + __builtin_amdgcn_logf(lsum);
}
__device__ __forceinline__ void attn_phase(LAS unsigned char* lds, unsigned char* ws, int bx, int G, int tid, int wave, int lane) {
    u32x4 kr[6], vr[6]; bf16x8 qn[4], qc[4];
    int u = (G % 8 == 0) ? (bx & 7) * (G >> 3) + (bx >> 3) : bx;
    if (u >= 1536) return;
    AttnU U = attn_decode(u); attn_load(U, ws, tid, wave, lane, kr, vr, qn);
    for (; u < 1536; u += G) {
        attn_stage(lds, tid, kr, vr);
#pragma unroll
        for (int kk = 0; kk < 4; ++kk) qc[kk] = qn[kk];
        __syncthreads();
        const AttnU Uc = U; const int un = u + G;
        if (un < 1536) { U = attn_decode(un); attn_load(U, ws, tid, wave, lane, kr, vr, qn); }
        attn_compute(Uc, lds, ws, wave, lane, qc);
        __syncthreads();
    }
}

__device__ __forceinline__ int psi(int j, int c) { return 32 * (j >> 1) + 8 * (c >> 2) + 4 * (j & 1) + (c & 3); }
__device__ __forceinline__ int kut_lds_off(int p) { const int dk = p >> 1; const int j = 2 * (dk >> 5) + ((dk >> 2) & 1), c = 4 * ((dk >> 3) & 3) + (dk & 3), g0 = 2 * (p & 1); return ((j * 4 + g0) * 16 + c) * 8; }

constexpr int P1_VT_OFF = 65536, P1_DEC_OFF = 131072;
__device__ __forceinline__ void hgrn_pass1(int item, LAS unsigned char* lds, unsigned char* ws, int tid, int wave, int lane) {
    const int seq = item >> 5, sc = item & 31, b = seq >> 2, h = seq & 3; const int g = lane >> 4, c = lane & 15;
    const int chunk0 = (b * SEQ + sc * 256) >> 4;
    const bf16* KUT = (const bf16*)(ws + WS_KUT); const bf16* VT = (const bf16*)(ws + WS_VT); const float* DEC = (const float*)(ws + WS_DEC);
    u32x4 st[8], sv[8];
#pragma unroll
    for (int it = 0; it < 8; ++it) { const int idx = tid + NTHR * it; const int ck = idx >> 8, p = idx & 255; const size_t go = ((size_t)(chunk0 + ck) * 512 + h * 128) * 16 + p * 8;
        st[it] = *(const u32x4*)(KUT + go); sv[it] = *(const u32x4*)(VT + go); }
    const f32x4 sd = *(const f32x4*)(DEC + (size_t)(chunk0 + (tid >> 5)) * 512 + h * 128 + 4 * (tid & 31));
#pragma unroll
    for (int it = 0; it < 8; ++it) { const int idx = tid + NTHR * it; const int ck = idx >> 8, p = idx & 255; LAS unsigned char* d = lds + ck * 4096 + kut_lds_off(p);
        *(LAS u32x2*)d = (u32x2){st[it].x, st[it].y}; *(LAS u32x2*)(d + 128) = (u32x2){st[it].z, st[it].w};
        *(LAS u32x4*)(lds + P1_VT_OFF + idx * 16) = sv[it]; }
    *(LAS f32x4*)(lds + P1_DEC_OFF + tid * 16) = sd;
    __syncthreads();
    f32x4 S[8], dt[8];
#pragma unroll
    for (int j = 0; j < 8; ++j) { S[j] = (f32x4){0.f, 0.f, 0.f, 0.f}; dt[j] = (f32x4){1.f, 1.f, 1.f, 1.f}; }
#pragma unroll 2
    for (int ck = 0; ck < 16; ++ck) {
        const s16x4 vb = *(const LAS s16x4*)(lds + P1_VT_OFF + ck * 4096 + ((16 * wave + c) * 16 + 4 * g) * 2);
#pragma unroll
        for (int j = 0; j < 8; ++j) {
            const s16x4 ka = *(const LAS s16x4*)(lds + ck * 4096 + ((j * 4 + g) * 16 + c) * 8);
            const f32x4 dc = *(const LAS f32x4*)(lds + P1_DEC_OFF + (ck * 128 + 32 * (j >> 1) + 8 * g + 4 * (j & 1)) * 4);
            S[j] = __builtin_amdgcn_mfma_f32_16x16x16bf16_1k(ka, vb, S[j] * dc, 0, 0, 0); dt[j] = dt[j] * dc;
        }
    }
    bf16* U = (bf16*)(ws + WS_U) + (size_t)item * 16384;
#pragma unroll
    for (int j = 0; j < 8; ++j) { u32x2 w; w.x = cvt_pk_bf16(S[j][0], S[j][1]); w.y = cvt_pk_bf16(S[j][2], S[j][3]); *(u32x2*)(U + ((wave * 8 + j) * 64 + lane) * 4) = w; }
    if (wave == 0 && c == 0) { float* D = (float*)(ws + WS_DTOT) + item * 128;
#pragma unroll
        for (int j = 0; j < 8; ++j) *(f32x4*)(D + 32 * (j >> 1) + 8 * g + 4 * (j & 1)) = dt[j]; }
    __syncthreads();
}

constexpr int OPITCH = 132, P3_QI = 16384, P3_KX = 32768, P3_VT = 49152, P3_DEC = 65536, P3_OT = 67584;
__device__ __forceinline__ void hgrn_pass3(int item, LAS unsigned char* lds, unsigned char* ws, const float* nw, int tid, int wave, int lane) {
    const int seq = item >> 5, sc = item & 31, b = seq >> 2, h = seq & 3; const int g = lane >> 4, c = lane & 15;
    const int tok0 = b * SEQ + sc * 256; const int chunk0 = tok0 >> 4;
    const bf16* KUT = (const bf16*)(ws + WS_KUT); const bf16* VT = (const bf16*)(ws + WS_VT); const float* DEC = (const float*)(ws + WS_DEC);
    const bf16* QI = (const bf16*)(ws + WS_QI); const bf16* GS = (const bf16*)(ws + WS_GS);
    bf16* MIX = (bf16*)(ws + WS_MIX);
    LAS float* ot = (LAS float*)(lds + P3_OT);
    f32x4 S[8];
    {
        const bf16* Ub = (const bf16*)(ws + WS_U) + (size_t)(seq * 32) * 16384 + (size_t)(wave * 8 * 64 + lane) * 4;
        const float* Db = (const float*)(ws + WS_DTOT) + (size_t)(seq * 32) * 128 + 8 * g;
        f32x4 W[8];
#pragma unroll
        for (int j = 0; j < 8; ++j) { S[j] = (f32x4){0.f, 0.f, 0.f, 0.f}; W[j] = (f32x4){1.f, 1.f, 1.f, 1.f}; }
        for (int k = sc - 1; k >= 0; k -= 2) {
            const int k2 = k > 0 ? k - 1 : 0;
            f32x4 u[8], d[8], u2[8], d2[8];
#pragma unroll
            for (int j = 0; j < 8; ++j) { const u32x2 a_ = *(const u32x2*)(Ub + (size_t)k * 16384 + j * 256), b_ = *(const u32x2*)(Ub + (size_t)k2 * 16384 + j * 256);
                u[j] = (f32x4){__uint_as_float(a_.x << 16), __uint_as_float(a_.x & 0xffff0000u), __uint_as_float(a_.y << 16), __uint_as_float(a_.y & 0xffff0000u)};
                u2[j] = (f32x4){__uint_as_float(b_.x << 16), __uint_as_float(b_.x & 0xffff0000u), __uint_as_float(b_.y << 16), __uint_as_float(b_.y & 0xffff0000u)};
                d[j] = *(const f32x4*)(Db + k * 128 + 32 * (j >> 1) + 4 * (j & 1)); d2[j] = *(const f32x4*)(Db + k2 * 128 + 32 * (j >> 1) + 4 * (j & 1)); }
            float live = 0.f;
#pragma unroll
            for (int j = 0; j < 8; ++j) { S[j] += W[j] * u[j]; W[j] = W[j] * d[j]; if (k > 0) { S[j] += W[j] * u2[j]; W[j] = W[j] * d2[j]; } live += (W[j][0] + W[j][1]) + (W[j][2] + W[j][3]); }
            if (!__any(live != 0.f)) break;
        }
    }
    const f32x4 n0 = *(const f32x4*)(nw + h * 128 + (tid & 15) * 8), n1 = *(const f32x4*)(nw + h * 128 + (tid & 15) * 8 + 4);
    u32x4 s_kut[2], s_vt[2], s_qi[2], s_gs[2]; float s_dinv[2]; f32x4 s_dec = (f32x4){0.f, 0.f, 0.f, 0.f};
#define P3_LOAD(q) do { \
        _Pragma("unroll") for (int it = 0; it < 2; ++it) { const int idx = tid + NTHR * it; const int ckl = idx >> 8, p = idx & 255; const int ckg = chunk0 + 4 * (q) + ckl; \
            s_kut[it] = *(const u32x4*)(KUT + ((size_t)ckg * 512 + h * 128) * 16 + p * 8); s_vt[it] = *(const u32x4*)(VT + ((size_t)ckg * 512 + h * 128) * 16 + p * 8); \
            const size_t to = (size_t)(ckg * 16 + (p >> 4)) * 512 + h * 128 + (p & 15) * 8; s_qi[it] = *(const u32x4*)(QI + to); s_dinv[it] = 1.0f / DEC[(size_t)ckg * 512 + h * 128 + (p >> 1)]; \
            s_gs[it] = *(const u32x4*)(GS + (size_t)(tok0 + 64 * (q) + (idx >> 4)) * 512 + h * 128 + (idx & 15) * 8); } \
        if (tid < 128) s_dec = *(const f32x4*)(DEC + (size_t)(chunk0 + 4 * (q) + (tid >> 5)) * 512 + h * 128 + 4 * (tid & 31)); \
    } while (0)
    P3_LOAD(0);
    for (int q = 0; q < 4; ++q) {
#pragma unroll
        for (int it = 0; it < 2; ++it) { const int idx = tid + NTHR * it; const int ckl = idx >> 8, p = idx & 255;
            LAS unsigned char* d = lds + ckl * 4096 + kut_lds_off(p);
            *(LAS u32x2*)d = (u32x2){s_kut[it].x, s_kut[it].y}; *(LAS u32x2*)(d + 128) = (u32x2){s_kut[it].z, s_kut[it].w};
            const int tl = p >> 4, dg = p & 15; const int fo = ckl * 4096 + (((dg >> 2) * 4 + (dg & 3)) * 16 + tl) * 16;
            *(LAS u32x4*)(lds + P3_QI + fo) = s_qi[it]; *(LAS u32x4*)(lds + P3_VT + idx * 16) = s_vt[it];
            { const int d = p >> 1; LAS unsigned char* kb = lds + P3_KX + ckl * 4096 + ((d >> 3) * 16 + 8 * (p & 1)) * 16 + (d & 7) * 2; const float di = s_dinv[it];
#pragma unroll
              for (int e8 = 0; e8 < 8; ++e8) { const unsigned wv = s_kut[it][e8 >> 1]; const float kuv = __uint_as_float((e8 & 1) ? (wv & 0xffff0000u) : (wv << 16));
                  *(LAS unsigned short*)(kb + e8 * 16) = cvt_bf16(kuv * di); } } }
        if (tid < 128) *(LAS f32x4*)(lds + P3_DEC + tid * 16) = s_dec;
        u32x4 gsc[2];
        gsc[0] = s_gs[0]; gsc[1] = s_gs[1];
        __syncthreads();
        if (q < 3) P3_LOAD(q + 1);
#pragma unroll 1
        for (int ckl = 0; ckl < 4; ++ckl) {
            const s16x4 vbc = *(const LAS s16x4*)(lds + P3_VT + ckl * 4096 + ((16 * wave + c) * 16 + 4 * g) * 2);
            bf16x8 kxf[4], qif[4];
#pragma unroll
            for (int kk = 0; kk < 4; ++kk) { const int fo = ckl * 4096 + ((kk * 4 + g) * 16 + c) * 16; kxf[kk] = *(const LAS bf16x8*)(lds + P3_KX + fo); qif[kk] = *(const LAS bf16x8*)(lds + P3_QI + fo); }
            f32x4 pt = (f32x4){0.f, 0.f, 0.f, 0.f};
#pragma unroll
            for (int kk = 0; kk < 4; ++kk) pt = __builtin_amdgcn_mfma_f32_16x16x32_bf16(kxf[kk], qif[kk], pt, 0, 0, 0);
#pragma unroll
            for (int i = 0; i < 4; ++i) if (4 * g + i > c) pt[i] = 0.f;
            u32x2 pw; pw.x = cvt_pk_bf16(pt[0], pt[1]); pw.y = cvt_pk_bf16(pt[2], pt[3]);
            f32x4 o0 = __builtin_amdgcn_mfma_f32_16x16x16bf16_1k(__builtin_bit_cast(s16x4, pw), vbc, (f32x4){0.f, 0.f, 0.f, 0.f}, 0, 0, 0);
            f32x4 o1 = (f32x4){0.f, 0.f, 0.f, 0.f};
#pragma unroll
            for (int j = 0; j < 8; ++j) {
                const bf16x8 qq = qif[j >> 1];
                const s16x4 qa = (j & 1) ? (s16x4){qq[4], qq[5], qq[6], qq[7]} : (s16x4){qq[0], qq[1], qq[2], qq[3]};
                u32x2 sw; sw.x = cvt_pk_bf16(S[j][0], S[j][1]); sw.y = cvt_pk_bf16(S[j][2], S[j][3]);
                if (j & 1) o1 = __builtin_amdgcn_mfma_f32_16x16x16bf16_1k(qa, __builtin_bit_cast(s16x4, sw), o1, 0, 0, 0);
                else       o0 = __builtin_amdgcn_mfma_f32_16x16x16bf16_1k(qa, __builtin_bit_cast(s16x4, sw), o0, 0, 0, 0);
            }
#pragma unroll
            for (int j = 0; j < 8; ++j) {
                const s16x4 ka = *(const LAS s16x4*)(lds + ckl * 4096 + ((j * 4 + g) * 16 + c) * 8);
                const f32x4 dc = *(const LAS f32x4*)(lds + P3_DEC + (ckl * 128 + 32 * (j >> 1) + 8 * g + 4 * (j & 1)) * 4);
                S[j] = __builtin_amdgcn_mfma_f32_16x16x16bf16_1k(ka, vbc, S[j] * dc, 0, 0, 0);
            }
            const f32x4 o = o0 + o1;
            LAS float* op = ot + (ckl * 16 + 4 * g) * OPITCH + 16 * wave + c;
#pragma unroll
            for (int i = 0; i < 4; ++i) op[i * OPITCH] = o[i];
        }
        __syncthreads();
#pragma unroll
        for (int it = 0; it < 2; ++it) {
            const int idx = tid + NTHR * it; const int tl = idx >> 4, d8 = (idx & 15) * 8; const int tok = tok0 + q * 64 + tl;
            const f32x4 v0 = *(const LAS f32x4*)(ot + tl * OPITCH + d8), v1 = *(const LAS f32x4*)(ot + tl * OPITCH + d8 + 4);
            const u32x4 gq = gsc[it];
            float ss = (v0[0] * v0[0] + v0[1] * v0[1]) + (v0[2] * v0[2] + v0[3] * v0[3]) + (v1[0] * v1[0] + v1[1] * v1[1]) + (v1[2] * v1[2] + v1[3] * v1[3]);
            ss += __shfl_xor(ss, 1); ss += __shfl_xor(ss, 2); ss += __shfl_xor(ss, 4); ss += __shfl_xor(ss, 8);
            const float rs = __builtin_amdgcn_rsqf(ss * (1.0f / 128.0f) + EPS);
            f32x4 y0 = v0 * rs * n0, y1 = v1 * rs * n1;
            y0[0] *= __uint_as_float(gq[0] << 16); y0[1] *= __uint_as_float(gq[0] & 0xffff0000u); y0[2] *= __uint_as_float(gq[1] << 16); y0[3] *= __uint_as_float(gq[1] & 0xffff0000u);
            y1[0] *= __uint_as_float(gq[2] << 16); y1[1] *= __uint_as_float(gq[2] & 0xffff0000u); y1[2] *= __uint_as_float(gq[3] << 16); y1[3] *= __uint_as_float(gq[3] & 0xffff0000u);
            u32x4 w; w.x = cvt_pk_bf16(y0[0], y0[1]); w.y = cvt_pk_bf16(y0[2], y0[3]); w.z = cvt_pk_bf16(y1[0], y1[1]); w.w = cvt_pk_bf16(y1[2], y1[3]);
            *(u32x4*)(MIX + (size_t)tok * 1024 + 512 + h * 128 + d8) = w;
        }
    }
    __syncthreads();
#undef P3_LOAD
}

__device__ __forceinline__ int affine_item(int c) { const int pm = 8 * (c & 7) + ((c >> 3) & 7), h = c >> 6; return (((pm >> 5) * 4 + h) << 5) + (pm & 31); }
__device__ __forceinline__ void attn_merge(unsigned char* ws, int gt, int NGT) {
    const bool aff = (NGT == 256 * NTHR); const int c_ = gt / NTHR, tl_ = gt % NTHR; const int tokb_ = 256 * (8 * (c_ & 7) + ((c_ >> 3) & 7)) + 64 * (c_ >> 6);
    const float* L = (const float*)(ws + WS_LSE); bf16* MIX = (bf16*)(ws + WS_MIX);
    const bf16* O0 = (const bf16*)(ws + WS_OP0); const bf16* O1 = (const bf16*)(ws + WS_OP1); const bf16* O2 = (const bf16*)(ws + WS_OP2);
#pragma unroll 4
    for (int idx = gt; idx < M * 64; idx += NGT) {
        const int k_ = idx / NGT, il_ = tl_ + NTHR * k_;
        const int tok = aff ? tokb_ + (il_ >> 6) : idx >> 6, hh = aff ? (il_ >> 3) & 7 : (idx >> 3) & 7, ch = aff ? il_ & 7 : idx & 7;
        const int bb = tok >> 13, tt = tok & (SEQ - 1); const size_t hb = (size_t)(bb * 8 + hh) * SEQ;
        const float l0 = L[hb + tt], l1 = L[(size_t)16 * SEQ + hb + (size_t)(tt & 3) * (SEQ >> 2) + (tt >> 2)], l2 = L[(size_t)32 * SEQ + hb + (size_t)(tt & 15) * (SEQ >> 4) + (tt >> 4)];
        const float mx = fmaxf(l0, fmaxf(l1, l2));
        float w0 = __builtin_amdgcn_exp2f(l0 - mx), w1 = __builtin_amdgcn_exp2f(l1 - mx), w2 = __builtin_amdgcn_exp2f(l2 - mx);
        const float inv = 1.0f / (w0 + w1 + w2); w0 *= inv; w1 *= inv; w2 *= inv;
        const size_t off = (size_t)tok * 512 + hh * 64 + ch * 8;
        const u32x4 a = *(const u32x4*)(O0 + off), bq = *(const u32x4*)(O1 + off), cq = *(const u32x4*)(O2 + off);
        u32x4 r;
#pragma unroll
        for (int k = 0; k < 4; ++k) {
            const float lo = w0 * __uint_as_float(a[k] << 16) + w1 * __uint_as_float(bq[k] << 16) + w2 * __uint_as_float(cq[k] << 16);
            const float hi = w0 * __uint_as_float(a[k] & 0xffff0000u) + w1 * __uint_as_float(bq[k] & 0xffff0000u) + w2 * __uint_as_float(cq[k] & 0xffff0000u);
            r[k] = cvt_pk_bf16(lo, hi);
        }
        *(u32x4*)(MIX + (size_t)tok * 1024 + hh * 64 + ch * 8) = r;
    }
}

__global__ void __launch_bounds__(NTHR, 2) fwd_megakernel(Args args) {
    extern __shared__ __attribute__((aligned(16))) unsigned char lds_raw[];
    LAS unsigned char* lds = (LAS unsigned char*)lds_raw;
    const int G = gridDim.x, bx = blockIdx.x;
    const int NGW = G * NWAVES, NGT = G * NTHR;
    unsigned char* ws = args.ws;
    volatile LAS unsigned* MISC = (volatile LAS unsigned*)(lds + LDS_BYTES - 128);
    if (threadIdx.x < 32) MISC[threadIdx.x] = 0u;
    __syncthreads();
    const XcdBarrier bar = xcd_barrier_post((unsigned*)(ws + WS_BAR), MISC + 8);
#define GRID_SYNC() xcd_barrier(bar)
#define PHASE_IDS() int tid = threadIdx.x; asm volatile("" : "+v"(tid)); const int lane = tid & 63, wave = __builtin_amdgcn_readfirstlane(tid >> 6); const int gw = bx * NWAVES + wave, gt = bx * NTHR + tid; (void)lane; (void)gw; (void)gt

    { PHASE_IDS(); p0_prologue(args, lds, gw, NGW, wave, lane);
    }
    GRID_SYNC();
    {
        pg8::Gemm g{(const pg8::bf16_t*)(ws + WS_XN), (const pg8::bf16_t*)(ws + WS_WIN), M, NIN, DM}; pg8::StaticOrder S; S.init(M, NIN, G, bx);
        pg8::EpiInProj E{ws};
        pg8::gemm_phase<pg8::EpiInProj, pg8::StaticOrder, true, true>(lds, g, S, E);
        if (bx >= 128) { PHASE_IDS(); convert_rest(args, lds, (bx - 128) * NWAVES + wave, (G - 128) * NWAVES, wave, lane); }
    }
    GRID_SYNC();
    { PHASE_IDS(); for (int it = bx; it < 256; it += G) hgrn_pass1(affine_item(it), lds, ws, tid, wave, lane);
    }
    { PHASE_IDS(); attn_phase(lds, ws, bx, G, tid, wave, lane);
    }
    GRID_SYNC();
    { PHASE_IDS(); for (int it = bx; it < 256; it += G) hgrn_pass3(affine_item(it), lds, ws, args.in[4], tid, wave, lane);
    }
    { PHASE_IDS(); attn_merge(ws, gt, NGT);
    }
    GRID_SYNC();
    {
        pg8::Gemm g{(const pg8::bf16_t*)(ws + WS_MIX), (const pg8::bf16_t*)(ws + WS_WOUT), M, DM, DM}; pg8::StaticOrder S; S.init(M, DM, G, bx);
        pg8::EpiOutProj E{args.in[0], (bf16*)(ws + WS_Q), (float*)(ws + WS_SS1)};
        pg8::gemm_phase<pg8::EpiOutProj, pg8::StaticOrder, true, true>(lds, g, S, E);
        { PHASE_IDS(); prefetch_lines(ws + WS_WGU, (NGU * DM * 2) / 128, gt, NGT); }
    }
    GRID_SYNC();
    {
        pg8::Gemm g{(const pg8::bf16_t*)(ws + WS_Q), (const pg8::bf16_t*)(ws + WS_WGU), M, NGU, DM}; pg8::StaticOrder S; S.init(M, NGU, G, bx);
        pg8::EpiGateUp E{(bf16*)(ws + WS_ACT), (const float*)(ws + WS_SS1)};
        pg8::gemm_phase<pg8::EpiGateUp, pg8::StaticOrder, true, true>(lds, g, S, E);
        { PHASE_IDS(); prefetch_lines(ws + WS_WDN, (DM * FFH * 2) / 128, gt, NGT); }
    }
    GRID_SYNC();
    {
        pg8::Gemm g{(const pg8::bf16_t*)(ws + WS_ACT), (const pg8::bf16_t*)(ws + WS_WDN), M, DM, FFH}; pg8::StaticOrder S; S.init(M, DM, G, bx);
        pg8::EpiDownNorm E{(const bf16*)(ws + WS_Q), args.out, (float*)(ws + WS_SS2), (unsigned*)(ws + WS_PCNT), args.in[9]};
        pg8::gemm_phase<pg8::EpiDownNorm, pg8::StaticOrder, false, true>(lds, g, S, E);
    }
}

extern "C" void kernel_launch(void* const* d_in, const int* in_sizes, int n_in, void* d_out, int out_size, void* d_ws, size_t ws_size, hipStream_t stream) {
    static int grid = 0;
    if (grid == 0) {
        if (n_in != 10 || in_sizes[0] != M * DM || out_size != M * DM || ws_size < WS_END) { fprintf(stderr, "kernel_launch: unexpected shapes (n_in %d in0 %d out %d ws %zu)\n", n_in, n_in > 0 ? in_sizes[0] : -1, out_size, ws_size); grid = -1; return; }
        int dev = 0, cus = 0, per_cu = 0;
        hipGetDevice(&dev); hipDeviceGetAttribute(&cus, hipDeviceAttributeMultiprocessorCount, dev);
        hipFuncSetAttribute((const void*)fwd_megakernel, hipFuncAttributeMaxDynamicSharedMemorySize, LDS_BYTES);
        hipOccupancyMaxActiveBlocksPerMultiprocessor(&per_cu, (const void*)fwd_megakernel, NTHR, LDS_BYTES);
        if (per_cu < 1) { fprintf(stderr, "kernel_launch: occupancy query says %d blocks per CU; nothing launched\n", per_cu); grid = -1; return; }
        (void)hipGetLastError();
        grid = cus * 1;
        if (grid != 256) { fprintf(stderr, "kernel_launch: this kernel needs exactly 256 CUs (got %d)\n", cus); grid = -1; return; }
    }
    if (grid < 0) return;
    if (hipMemsetAsync(d_ws, 0, WS_ZERO_BYTES, stream) != hipSuccess) { fprintf(stderr, "kernel_launch: memset failed\n"); return; }
    Args a{};
    for (int i = 0; i < 10; ++i) a.in[i] = (const float*)d_in[i];
    a.out = (float*)d_out; a.ws = (unsigned char*)d_ws;
    void* kargs[] = {&a};
    hipError_t e = hipLaunchCooperativeKernel((const void*)fwd_megakernel, dim3(grid), dim3(NTHR), kargs, LDS_BYTES, stream);
    if (e != hipSuccess) fprintf(stderr, "cooperative launch failed: %s (grid %d)\n", hipGetErrorString(e), grid);
}
```

```cpp
#include <hip/hip_runtime.h>
#include <cstdio>
#include <cstdint>
constexpr int SEQ = 8192, DM = 1024, M = 2 * SEQ, NIN = 3584, FFH = 2816, NGU = 2 * FFH;
constexpr float EPS = 1e-6f;
constexpr int NWAVES = 8, NTHR = 512;
constexpr size_t MiB = 1u << 20;
constexpr size_t WS_SS1 = 0, WS_SS2 = 65536;
constexpr size_t WS_BAR = 131072;
constexpr size_t WS_ZERO_BYTES = 163840;
constexpr size_t WS_DTOT = 262144;
constexpr size_t WS_LB = 393216;
constexpr size_t WS_PCNT = 147456;
constexpr size_t WS_RSINV = 409600;
constexpr size_t WS_WIN = MiB / 2;
constexpr size_t WS_WOUT = WS_WIN + 7 * MiB;
constexpr size_t WS_WGU = WS_WOUT + 2 * MiB;
constexpr size_t WS_WDN = WS_WGU + 11 * MiB;
constexpr size_t WS_ROPE = WS_WDN + 11 * MiB / 2;
constexpr size_t WS_DEC = WS_ROPE + 2 * MiB;
constexpr size_t WS_LSE = WS_DEC + 2 * MiB;
static_assert(WS_LSE + 3 * MiB / 2 <= 32 * MiB, "region A");
constexpr size_t WS_XN = 32 * MiB;
constexpr size_t WS_OP0 = 32 * MiB, WS_OP1 = 48 * MiB;
constexpr size_t WS_MIX = 64 * MiB;
constexpr size_t WS_Q = 96 * MiB, WS_K = 112 * MiB, WS_V = 128 * MiB, WS_OP2 = 144 * MiB;
constexpr size_t WS_QI = 160 * MiB, WS_KX = 176 * MiB, WS_KUT = 192 * MiB, WS_VT = 208 * MiB, WS_GS = 224 * MiB, WS_U = 240 * MiB;
constexpr size_t WS_ACT = 160 * MiB;
constexpr size_t WS_END = 256 * MiB;
namespace pg8 {
#define PG8_LAS __attribute__((address_space(3)))
typedef unsigned short bf16_t;
typedef short bf16x8 __attribute__((ext_vector_type(8)));
typedef float f32x4 __attribute__((ext_vector_type(4)));
typedef unsigned u32x4 __attribute__((ext_vector_type(4))); typedef unsigned u32x2 __attribute__((ext_vector_type(2)));
constexpr int BM = 256, BK = 64, HALF = 128, HTB = HALF * BK * 2  , STAGE_BYTES = 8 * HTB, NXCD = 8, WGM = 8;

__host__ __device__ __forceinline__ int lds_byte(int r, int c) { const int st = (r >> 4) * 2 + (c >> 5), rr = r & 15, cc = c & 31, ob = rr * 64 + cc * 2; return st * 1024 + (ob ^ (((ob >> 9) & 1) << 5)); }
__host__ __device__ __forceinline__ void stage_rc(int b, int& R, int& C) { const int st = b / 1024, sb = b % 1024, swz = sb ^ (((sb >> 9) & 1) << 5); R = (st >> 1) * 16 + swz / 64; C = (st & 1) * 32 + (swz % 64) / 2; }
__host__ __device__ __forceinline__ int perm32(int rho) { const int n = rho >> 4, i = rho & 15; return 8 * (i >> 2) + 4 * n + (i & 3); }

struct Unit { int pm, pn; };
struct Gemm { const bf16_t* A; const bf16_t* Bt; int M, N, K; };

struct StaticOrder {
    int nM, nN, nwg, G, c;
    __host__ __device__ void init(int M, int N, int G_, int c_) { nM = M / BM; nN = N / BM; nwg = nM * nN; G = G_; c = c_; }
    __host__ __device__ bool next(int i, Unit& u) const {
        const long L = (long)i * G + c; if (L >= nwg) return false;
        int wgid = (int)L; { const int q = nwg / NXCD, r = nwg % NXCD, xcd = wgid % NXCD, off = wgid / NXCD; wgid = (xcd < r ? xcd * (q + 1) : r * (q + 1) + (xcd - r) * q) + off; }
        const int nig = WGM * nN, gid = wgid / nig, fm = gid * WGM, gsz = (nM - fm) < WGM ? (nM - fm) : WGM;
        u.pm = fm + ((wgid % nig) % gsz); u.pn = (wgid % nig) / gsz; return true;
    }
    __device__ __forceinline__ void a_ready(const Unit&) const {}
    __device__ __forceinline__ void done(const Unit&) const {}
};

__device__ __forceinline__ unsigned cvt_pk_bf16(float lo, float hi) { unsigned r; asm volatile("v_cvt_pk_bf16_f32 %0, %1, %2" : "=v"(r) : "v"(lo), "v"(hi)); return r; }
__device__ __forceinline__ unsigned short cvt_bf16(float x) { return (unsigned short)(cvt_pk_bf16(x, 0.f) & 0xffffu); }
__device__ __forceinline__ float sigmoidf_(float x) { return __builtin_amdgcn_rcpf(1.0f + __expf(-x)); }
__device__ __forceinline__ u32x4 pack8(const f32x4 a, const f32x4 b) { u32x4 w; w.x = cvt_pk_bf16(a[0], a[1]); w.y = cvt_pk_bf16(a[2], a[3]); w.z = cvt_pk_bf16(b[0], b[1]); w.w = cvt_pk_bf16(b[2], b[3]); return w; }

template <int CTRL> __device__ __forceinline__ float dpp1_f(float x) { return __int_as_float(__builtin_amdgcn_update_dpp(0x3f800000, __float_as_int(x), CTRL, 0xf, 0xf, false)); }
template <int CTRL> __device__ __forceinline__ float dpp_f(float x) { return __int_as_float(__builtin_amdgcn_update_dpp(0, __float_as_int(x), CTRL, 0xf, 0xf, true)); }
constexpr float QSCALE = 0.125f * 1.4426950408889634f;

struct EpiInProj {
    static constexpr bool PERM = true, AFTER_DRAIN = false;
    unsigned char* ws;
    __device__ __forceinline__ void operator()(const f32x4 (&acc)[2][2][4][2], const Unit& u, int wr, int wc, int fr, int fq) const {
        const int pn = u.pn; const int row0 = u.pm * BM + wr * 64 + fr;
        if (pn < 4) {
            const float* rope = (const float*)(ws + WS_ROPE);
            bf16_t* dst = (bf16_t*)(ws + ((pn < 2) ? WS_Q : WS_K)); const float sc = (pn < 2) ? QSCALE : 1.0f;
            const int col = 256 * (pn & 1) + 64 * wc + 8 * fq;
#pragma unroll
            for (int ai = 0; ai < 2; ++ai)
#pragma unroll
                for (int m = 0; m < 4; ++m) {
                    const int row = row0 + ai * HALF + m * 16; const int t = row & 8191;
                    const float* cp = rope + (size_t)t * 32 + 8 * fq; const float* sp = cp + 8192 * 32;
                    const f32x4 c0 = *(const f32x4*)cp, c1 = *(const f32x4*)(cp + 4), s0 = *(const f32x4*)sp, s1 = *(const f32x4*)(sp + 4);
                    const f32x4 a0 = acc[ai][0][m][0], a1 = acc[ai][0][m][1], b0 = acc[ai][1][m][0], b1 = acc[ai][1][m][1];
                    const f32x4 o10 = (a0 * c0 - b0 * s0) * sc, o11 = (a1 * c1 - b1 * s1) * sc, o20 = (b0 * c0 + a0 * s0) * sc, o21 = (b1 * c1 + a1 * s1) * sc;
                    bf16_t* rp = dst + (size_t)row * 512 + col;
                    *(u32x4*)rp = pack8(o10, o11); *(u32x4*)(rp + 32) = pack8(o20, o21);
                    asm volatile("" ::: "memory");
                }
        } else if (pn < 6) {
            bf16_t* V = (bf16_t*)(ws + WS_V);
            const int col = 256 * (pn - 4) + 32 * wc + 8 * fq;
#pragma unroll
            for (int ai = 0; ai < 2; ++ai)
#pragma unroll
                for (int m = 0; m < 4; ++m) {
                    const int row = row0 + ai * HALF + m * 16; bf16_t* rp = V + (size_t)row * 512 + col;
                    *(u32x4*)rp = pack8(acc[ai][0][m][0], acc[ai][0][m][1]); *(u32x4*)(rp + HALF) = pack8(acc[ai][1][m][0], acc[ai][1][m][1]);
                }
        } else {
            const int th = pn - 6; const int dbase = 64 * th + 16 * wc + 4 * fq;
            bf16_t* QI = (bf16_t*)(ws + WS_QI); bf16_t* KUT = (bf16_t*)(ws + WS_KUT); float* DEC = (float*)(ws + WS_DEC);
            bf16_t* VT = (bf16_t*)(ws + WS_VT); bf16_t* GS = (bf16_t*)(ws + WS_GS);
            const f32x4 lb4 = *(const f32x4*)((const float*)(ws + WS_LB) + dbase);
            constexpr float L2E = 1.4426950408889634f;
#pragma unroll
            for (int ai = 0; ai < 2; ++ai)
#pragma unroll
                for (int m = 0; m < 4; ++m) {
                    const int row = row0 + ai * HALF + m * 16; const unsigned chunk = (unsigned)row >> 4;
                    const unsigned ro = (unsigned)row * 512u + (unsigned)dbase, co = chunk * 512u + (unsigned)dbase, to = co * 16u + (unsigned)fr;
                    float qi[4], kx[4], dc[4];
#pragma unroll
                    for (int e = 0; e < 4; ++e) {
                        const float lbv = lb4[e], omlb = 1.0f - lbv;
                        const float qv = acc[ai][0][m][0][e], fv = acc[ai][1][m][0][e];
                        const float sg = __builtin_amdgcn_rcpf(1.0f + __builtin_amdgcn_exp2f(-L2E * fv)); const float f = lbv + omlb * sg; const float omf = omlb * (1.0f - sg);
                        float eb = f; eb *= dpp1_f<0x111>(eb); eb *= dpp1_f<0x112>(eb); eb *= dpp1_f<0x114>(eb); eb *= dpp1_f<0x118>(eb);
                        float ebl = f; ebl *= dpp1_f<0x128>(ebl); ebl *= dpp1_f<0x124>(ebl); ebl *= dpp1_f<0x122>(ebl); ebl *= dpp1_f<0x121>(ebl);
                        const float enb = __builtin_amdgcn_rcpf(eb);
                        const float sq = qv * __builtin_amdgcn_rcpf(1.0f + __builtin_amdgcn_exp2f(-L2E * qv));
                        qi[e] = sq * eb; kx[e] = omf * enb; dc[e] = ebl;
                        KUT[to + e * 16u] = cvt_bf16(kx[e] * ebl);
                        VT[to + e * 16u] = cvt_bf16(acc[ai][0][m][1][e]);
                    }
                    u32x2 w; w.x = cvt_pk_bf16(qi[0], qi[1]); w.y = cvt_pk_bf16(qi[2], qi[3]); *(u32x2*)(QI + ro) = w;
                    if (fr == 0) *(f32x4*)(DEC + co) = (f32x4){dc[0], dc[1], dc[2], dc[3]};
                    f32x4 gv = acc[ai][1][m][1];
#pragma unroll
                    for (int e = 0; e < 4; ++e) gv[e] = gv[e] * __builtin_amdgcn_rcpf(1.0f + __builtin_amdgcn_exp2f(-L2E * gv[e]));
                    w.x = cvt_pk_bf16(gv[0], gv[1]); w.y = cvt_pk_bf16(gv[2], gv[3]); *(u32x2*)(GS + ro) = w;
                    asm volatile("" ::: "memory");
                }
        }
    }
};

struct EpiOutProj {
    static constexpr bool PERM = true, AFTER_DRAIN = false;
    const float* X; bf16_t* HR; float* SS;
    __device__ __forceinline__ void operator()(const f32x4 (&acc)[2][2][4][2], const Unit& u, int wr, int wc, int fr, int fq) const {
        const int row0 = u.pm * BM + wr * 64 + fr; const int col0 = u.pn * BM + wc * 32 + 8 * fq;
        f32x4 xn[2][2];
        { const size_t off = (size_t)row0 * 1024 + col0;
#pragma unroll
          for (int bj = 0; bj < 2; ++bj) { xn[bj][0] = *(const f32x4*)(X + off + bj * HALF); xn[bj][1] = *(const f32x4*)(X + off + bj * HALF + 4); } }
#pragma unroll
        for (int i = 0; i < 8; ++i) {
            const int ai = i >> 2, m = i & 3;
            const int row = row0 + ai * HALF + m * 16; const size_t off = (size_t)row * 1024 + col0; float s = 0.f;
            f32x4 xc[2][2];
#pragma unroll
            for (int bj = 0; bj < 2; ++bj) { xc[bj][0] = xn[bj][0]; xc[bj][1] = xn[bj][1]; }
            if (i < 7) { const int rown = row0 + ((i + 1) >> 2) * HALF + ((i + 1) & 3) * 16; const size_t offn = (size_t)rown * 1024 + col0;
#pragma unroll
                for (int bj = 0; bj < 2; ++bj) { xn[bj][0] = *(const f32x4*)(X + offn + bj * HALF); xn[bj][1] = *(const f32x4*)(X + offn + bj * HALF + 4); } }
#pragma unroll
            for (int bj = 0; bj < 2; ++bj) {
                const f32x4 h0 = xc[bj][0] + acc[ai][bj][m][0], h1 = xc[bj][1] + acc[ai][bj][m][1];
                *(u32x4*)(HR + off + bj * HALF) = pack8(h0, h1);
                s += (h0[0] * h0[0] + h0[1] * h0[1]) + (h0[2] * h0[2] + h0[3] * h0[3]) + (h1[0] * h1[0] + h1[1] * h1[1]) + (h1[2] * h1[2] + h1[3] * h1[3]);
            }
            s += __shfl_xor(s, 16); s += __shfl_xor(s, 32);
            if (fq == 0) atomicAdd(SS + row, s);
            asm volatile("" ::: "memory");
        }
    }
};

struct EpiGateUp {
    static constexpr bool PERM = true, AFTER_DRAIN = false;
    bf16_t* ACT; const float* SS;
    __device__ __forceinline__ void operator()(const f32x4 (&acc)[2][2][4][2], const Unit& u, int wr, int wc, int fr, int fq) const {
        const int row0 = u.pm * BM + wr * 64 + fr; const int col0 = u.pn * HALF + wc * 32 + 8 * fq;
#pragma unroll
        for (int ai = 0; ai < 2; ++ai)
#pragma unroll
            for (int m = 0; m < 4; ++m) {
                const int row = row0 + ai * HALF + m * 16; const float rs = __builtin_amdgcn_rsqf(SS[row] * (1.0f / 1024.0f) + 1e-6f);
                f32x4 a0, a1;
#pragma unroll
                for (int e = 0; e < 4; ++e) { const float g0 = acc[ai][0][m][0][e] * rs, u0 = acc[ai][1][m][0][e] * rs, g1 = acc[ai][0][m][1][e] * rs, u1 = acc[ai][1][m][1][e] * rs;
                    a0[e] = g0 * sigmoidf_(g0) * u0; a1[e] = g1 * sigmoidf_(g1) * u1; }
                *(u32x4*)(ACT + (size_t)row * 2816 + col0) = pack8(a0, a1);
            }
    }
};

struct EpiDownNorm {
    static constexpr bool PERM = true, AFTER_DRAIN = true;
    const bf16_t* HR; float* OUT; float* SS; unsigned* cnt; const float* fw;
    __device__ __forceinline__ void fused(f32x4 (&acc)[2][2][4][2], const Unit& u, int wr, int wc, int fr, int fq, PG8_LAS unsigned char* lds, int wid, int lane) const {
        const int row0 = u.pm * BM + wr * 64 + fr; const int col0 = u.pn * BM + wc * 32 + 8 * fq;
        float olds[8] = {0.f, 0.f, 0.f, 0.f, 0.f, 0.f, 0.f, 0.f};
#pragma unroll
        for (int ai = 0; ai < 2; ++ai)
#pragma unroll
            for (int m = 0; m < 4; ++m) {
                const int row = row0 + ai * HALF + m * 16; const unsigned off = (unsigned)row * 1024u + (unsigned)col0; float s = 0.f;
#pragma unroll
                for (int bj = 0; bj < 2; ++bj) {
                    const u32x4 hr = *(const u32x4*)(HR + off + bj * HALF);
                    const f32x4 r0 = (f32x4){__uint_as_float(hr.x << 16), __uint_as_float(hr.x & 0xffff0000u), __uint_as_float(hr.y << 16), __uint_as_float(hr.y & 0xffff0000u)};
                    const f32x4 r1 = (f32x4){__uint_as_float(hr.z << 16), __uint_as_float(hr.z & 0xffff0000u), __uint_as_float(hr.w << 16), __uint_as_float(hr.w & 0xffff0000u)};
                    const f32x4 h0 = r0 + acc[ai][bj][m][0], h1 = r1 + acc[ai][bj][m][1];
                    acc[ai][bj][m][0] = h0; acc[ai][bj][m][1] = h1;
                    s += (h0[0] * h0[0] + h0[1] * h0[1]) + (h0[2] * h0[2] + h0[3] * h0[3]) + (h1[0] * h1[0] + h1[1] * h1[1]) + (h1[2] * h1[2] + h1[3] * h1[3]);
                }
                s += __shfl_xor(s, 16); s += __shfl_xor(s, 32);
                if (fq == 0) olds[ai * 4 + m] = atomicAdd(SS + row, s);
            }
#pragma unroll
        for (int i = 0; i < 8; ++i) asm volatile("" :: "v"(olds[i]));
        asm volatile("s_waitcnt vmcnt(0)" ::: "memory");
        __syncthreads();
        if (wid == 0 && lane == 0) {
            __hip_atomic_fetch_add(cnt + 64 * u.pm, 1u, __ATOMIC_RELAXED, __HIP_MEMORY_SCOPE_AGENT);
            unsigned sp = 0;
            while (__hip_atomic_load(cnt + 64 * u.pm, __ATOMIC_RELAXED, __HIP_MEMORY_SCOPE_AGENT) < 4u) { __builtin_amdgcn_s_sleep(1); if (++sp > (1u << 22)) break; }
        }
        __syncthreads();
        f32x4 w[2][2];
#pragma unroll
        for (int bj = 0; bj < 2; ++bj)
#pragma unroll
            for (int n = 0; n < 2; ++n) w[bj][n] = *(const f32x4*)(fw + col0 + bj * HALF + 4 * n);
        float tots[8];
#pragma unroll
        for (int i = 0; i < 8; ++i) { tots[i] = 0.f; if (fq == 0) tots[i] = atomicAdd(SS + row0 + (i >> 2) * HALF + (i & 3) * 16, 0.0f); }
#pragma unroll
        for (int ai = 0; ai < 2; ++ai)
#pragma unroll
            for (int m = 0; m < 4; ++m) {
                const int row = row0 + ai * HALF + m * 16; const unsigned off = (unsigned)row * 1024u + (unsigned)col0;
                const float tot = __shfl(tots[ai * 4 + m], fr, 64);
                const float rs = __builtin_amdgcn_rsqf(tot * (1.0f / 1024.0f) + 1e-6f);
#pragma unroll
                for (int bj = 0; bj < 2; ++bj) {
                    *(f32x4*)(OUT + off + bj * HALF) = acc[ai][bj][m][0] * rs * w[bj][0]; *(f32x4*)(OUT + off + bj * HALF + 4) = acc[ai][bj][m][1] * rs * w[bj][1];
                }
                asm volatile("" ::: "memory");
            }
    }
};

template <class Epi, class Sched, bool ALIGN_EPI = false, bool SP2 = false>
__device__ __forceinline__ void gemm_phase(PG8_LAS unsigned char* lds, const Gemm g, const Sched& S, const Epi& E) {
    int tid_ = threadIdx.x; asm volatile("" : "+v"(tid_));
    const int tid = tid_, wid = __builtin_amdgcn_readfirstlane(tid >> 6), lane = tid & 63, wr = wid >> 2, wc = wid & 3, fr = lane & 15, fq = lane >> 4;
    const int K = g.K, nt = K / BK;
    unsigned voffA[2], voffB[2];
#pragma unroll
    for (int i = 0; i < 2; ++i) { int R, C; stage_rc(tid * 16 + i * 8192, R, C); const int Rb = Epi::PERM ? ((R & ~31) + perm32(R & 31)) : R;
        voffA[i] = (unsigned)(R * K + C) * 2u; voffB[i] = (unsigned)(Rb * K + C) * 2u; }
    const size_t kstep = (size_t)(BK * 2);
    const size_t hstep = (size_t)HALF * K * 2;
    const size_t tstep = 2 * hstep;
    const unsigned ldsw = (unsigned)wid * 1024u;
    const int aoff = lds_byte(wr * 64 + fr, fq * 8), boff = lds_byte(wc * 32 + fr, fq * 8);
#define PG8_SA(b, h) (((b) * 2 + (h)) * HTB)
#define PG8_SB(b, h) ((4 + (b) * 2 + (h)) * HTB)
#define PG8_STAGE(bufoff, gbase, voff) do { _Pragma("unroll") for (int _i = 0; _i < 2; ++_i) \
        __builtin_amdgcn_global_load_lds((const unsigned*)((const char*)(gbase) + (voff)[_i]), (PG8_LAS unsigned*)(lds + (bufoff) + ldsw + _i * 8192), 16, 0, 0); } while (0)
#define PG8_LDA(dst, b, h) do { _Pragma("unroll") for (int m = 0; m < 4; ++m) _Pragma("unroll") for (int k = 0; k < 2; ++k) dst[m][k] = *(const PG8_LAS bf16x8*)(lds + PG8_SA(b, h) + aoff + m * 2048 + k * 1024); } while (0)
#define PG8_LDB(dst, b, h) do { _Pragma("unroll") for (int n = 0; n < 2; ++n) _Pragma("unroll") for (int k = 0; k < 2; ++k) dst[n][k] = *(const PG8_LAS bf16x8*)(lds + PG8_SB(b, h) + boff + n * 2048 + k * 1024); } while (0)
#define PG8_MMA(ai, bj, At, Bt) do { __builtin_amdgcn_s_setprio(1); _Pragma("unroll") for (int m = 0; m < 4; ++m) _Pragma("unroll") for (int n = 0; n < 2; ++n) _Pragma("unroll") for (int k = 0; k < 2; ++k) \
        acc[ai][bj][m][n] = __builtin_amdgcn_mfma_f32_16x16x32_bf16(Bt[n][k], At[m][k], acc[ai][bj][m][n], 0, 0, 0); __builtin_amdgcn_s_setprio(0); } while (0)
#define PG8_WAIT_V(n) asm volatile("s_waitcnt vmcnt(" #n ")" ::: "memory")
#define PG8_WAIT_L(n) asm volatile("s_waitcnt lgkmcnt(" #n ")" ::: "memory")
#define PG8_BAR __builtin_amdgcn_s_barrier()
#define PG8_SCHED __builtin_amdgcn_sched_barrier(0)
    Unit cur, nxt; int ui = 0;
    if (!S.next(0, cur)) return;
    f32x4 acc[2][2][4][2];
#pragma unroll
    for (int a = 0; a < 2; ++a)
#pragma unroll
        for (int b = 0; b < 2; ++b)
#pragma unroll
            for (int m = 0; m < 4; ++m)
#pragma unroll
                for (int n = 0; n < 2; ++n) acc[a][b][m][n] = (f32x4){0.f, 0.f, 0.f, 0.f};
    bf16x8 At[4][2], B0[2][2], B1[2][2];
    const char* cA = (const char*)g.A + (size_t)cur.pm * tstep; const char* cB = (const char*)g.Bt + (size_t)cur.pn * tstep;
    S.a_ready(cur);
    if constexpr (SP2) {
        PG8_STAGE(PG8_SB(0, 0), cB, voffB); PG8_STAGE(PG8_SB(0, 1), cB + hstep, voffB); PG8_STAGE(PG8_SA(0, 0), cA, voffA); PG8_STAGE(PG8_SA(0, 1), cA + hstep, voffA);
        if (wr == 1) PG8_BAR;
        PG8_WAIT_V(2); PG8_BAR;
        PG8_STAGE(PG8_SB(1, 0), cB + kstep, voffB); PG8_STAGE(PG8_SA(1, 0), cA + kstep, voffA); PG8_STAGE(PG8_SB(1, 1), cB + hstep + kstep, voffB);
        PG8_WAIT_V(6); PG8_BAR;
    } else {
        PG8_STAGE(PG8_SB(0, 0), cB, voffB); PG8_STAGE(PG8_SA(0, 0), cA, voffA); PG8_STAGE(PG8_SB(0, 1), cB + hstep, voffB); PG8_STAGE(PG8_SA(0, 1), cA + hstep, voffA);
        if (wr == 1) PG8_BAR;
        PG8_WAIT_V(4); PG8_BAR;
        PG8_STAGE(PG8_SB(1, 0), cB + kstep, voffB); PG8_STAGE(PG8_SA(1, 0), cA + kstep, voffA); PG8_STAGE(PG8_SB(1, 1), cB + hstep + kstep, voffB);
        PG8_WAIT_V(6); PG8_BAR;
    }
    for (;;) {
        const bool has_next = S.next(ui + 1, nxt);
        const char* nA = has_next ? (const char*)g.A + (size_t)nxt.pm * tstep : cA; const char* nB = has_next ? (const char*)g.Bt + (size_t)nxt.pn * tstep : cB;
        for (int t = 0; t < nt; t += 2) {
            const bool last = (t == nt - 2);
            const char* a1 = cA + (size_t)(t + 1) * kstep;
            const char* a2 = last ? nA : cA + (size_t)(t + 2) * kstep; const char* b2 = last ? nB : cB + (size_t)(t + 2) * kstep;
            const char* a3 = a2 + kstep; const char* b3 = b2 + kstep;
            if (last && has_next) S.a_ready(nxt);
            if constexpr (SP2) {
            PG8_LDB(B0, 0, 0); PG8_LDB(B1, 0, 1); PG8_SCHED; PG8_LDA(At, 0, 0); PG8_STAGE(PG8_SA(1, 1), a1 + hstep, voffA);
            PG8_WAIT_V(8); PG8_WAIT_L(0); PG8_BAR; PG8_MMA(0, 0, At, B0); PG8_MMA(0, 1, At, B1); PG8_BAR; PG8_SCHED;
            PG8_LDA(At, 0, 1); PG8_STAGE(PG8_SB(0, 0), b2, voffB); PG8_STAGE(PG8_SB(0, 1), b2 + hstep, voffB); PG8_STAGE(PG8_SA(0, 0), a2, voffA);
            PG8_WAIT_V(8); PG8_WAIT_L(0); PG8_BAR; PG8_MMA(1, 0, At, B0); PG8_MMA(1, 1, At, B1); PG8_BAR; PG8_SCHED;
            PG8_LDB(B0, 1, 0); PG8_LDB(B1, 1, 1); PG8_SCHED; PG8_LDA(At, 1, 0); PG8_STAGE(PG8_SA(0, 1), a2 + hstep, voffA);
            PG8_WAIT_V(8); PG8_WAIT_L(0); PG8_BAR; PG8_MMA(0, 0, At, B0); PG8_MMA(0, 1, At, B1); PG8_BAR; PG8_SCHED;
            PG8_LDA(At, 1, 1); PG8_STAGE(PG8_SB(1, 0), b3, voffB); PG8_STAGE(PG8_SB(1, 1), b3 + hstep, voffB); PG8_STAGE(PG8_SA(1, 0), a3, voffA);
            PG8_WAIT_V(8); PG8_WAIT_L(0); PG8_BAR; PG8_MMA(1, 0, At, B0); PG8_MMA(1, 1, At, B1); PG8_BAR; PG8_SCHED;
            } else {
            PG8_LDB(B0, 0, 0); PG8_SCHED; PG8_LDA(At, 0, 0); PG8_STAGE(PG8_SA(1, 1), a1 + hstep, voffA);
            PG8_WAIT_L(8); PG8_BAR; PG8_WAIT_L(0); PG8_MMA(0, 0, At, B0); PG8_BAR; PG8_SCHED;
            PG8_LDB(B1, 0, 1); PG8_STAGE(PG8_SB(0, 0), b2, voffB);
            PG8_BAR; PG8_WAIT_L(0); PG8_MMA(0, 1, At, B1); PG8_BAR;
            PG8_LDA(At, 0, 1); PG8_STAGE(PG8_SA(0, 0), a2, voffA);
            PG8_BAR; PG8_WAIT_L(0); PG8_MMA(1, 0, At, B0); PG8_BAR; PG8_SCHED;
            PG8_STAGE(PG8_SB(0, 1), b2 + hstep, voffB);
            PG8_WAIT_V(6); PG8_BAR; PG8_MMA(1, 1, At, B1); PG8_BAR;
            PG8_LDB(B0, 1, 0); PG8_SCHED; PG8_LDA(At, 1, 0); PG8_STAGE(PG8_SA(0, 1), a2 + hstep, voffA);
            PG8_WAIT_L(8); PG8_BAR; PG8_WAIT_L(0); PG8_MMA(0, 0, At, B0); PG8_BAR; PG8_SCHED;
            PG8_LDB(B1, 1, 1); PG8_STAGE(PG8_SB(1, 0), b3, voffB);
            PG8_BAR; PG8_WAIT_L(0); PG8_MMA(0, 1, At, B1); PG8_BAR;
            PG8_LDA(At, 1, 1); PG8_STAGE(PG8_SA(1, 0), a3, voffA);
            PG8_BAR; PG8_WAIT_L(0); PG8_MMA(1, 0, At, B0); PG8_BAR; PG8_SCHED;
            PG8_STAGE(PG8_SB(1, 1), b3 + hstep, voffB);
            PG8_WAIT_V(6); PG8_BAR; PG8_MMA(1, 1, At, B1); PG8_BAR;
            }
        }
        if constexpr (ALIGN_EPI) { if (wr == 0) PG8_BAR; }
        if constexpr (!Epi::AFTER_DRAIN) { E(acc, cur, wr, wc, fr, fq); S.done(cur); }
        if (!has_next) break;
#pragma unroll
        for (int a = 0; a < 2; ++a)
#pragma unroll
            for (int b = 0; b < 2; ++b)
#pragma unroll
                for (int m = 0; m < 4; ++m)
#pragma unroll
                    for (int n = 0; n < 2; ++n) acc[a][b][m][n] = (f32x4){0.f, 0.f, 0.f, 0.f};
        cur = nxt; cA = nA; cB = nB; ++ui;
        if constexpr (ALIGN_EPI) { if (wr == 1) PG8_BAR; }
    }
    PG8_WAIT_V(0);
    if constexpr (!ALIGN_EPI) { if (wr == 0) PG8_BAR; }
    PG8_BAR;
    if constexpr (Epi::AFTER_DRAIN) { E.fused(acc, cur, wr, wc, fr, fq, lds, wid, lane); S.done(cur); }
#undef PG8_SA
#undef PG8_SB
#undef PG8_STAGE
#undef PG8_LDA
#undef PG8_LDB
#undef PG8_MMA
#undef PG8_WAIT_V
#undef PG8_WAIT_L
#undef PG8_BAR
#undef PG8_SCHED
}
}

constexpr int RING_BYTES = 131072, LDS_BYTES = 147456;

#define GAS __attribute__((address_space(1)))
#define LAS __attribute__((address_space(3)))
typedef unsigned short bf16;
typedef float f32x4 __attribute__((ext_vector_type(4)));
typedef float f32x16 __attribute__((ext_vector_type(16)));
typedef short bf16x8 __attribute__((ext_vector_type(8)));
typedef short s16x4 __attribute__((ext_vector_type(4)));
typedef unsigned u32x4 __attribute__((ext_vector_type(4)));
typedef unsigned u32x2 __attribute__((ext_vector_type(2)));
using pg8::cvt_pk_bf16; using pg8::cvt_bf16;

__device__ __forceinline__ float bf2f(unsigned short h) { return __uint_as_float(((unsigned)h) << 16); }

__device__ __forceinline__ int bt_row_inproj(int c) {
    if (c < 1024) { const int region = c >> 9, cc = c & 511; const int tr = cc >> 8, hl = (cc >> 6) & 3, half = (cc >> 5) & 1, idx = cc & 31; return 256 * (2 * region + tr) + 128 * half + 32 * hl + idx; }
    if (c < 1536) return c;
    const int cc = c - 1536; const int arr = cc >> 9, d = cc & 511; const int th = d >> 6, dd = d & 63;
    return 256 * (6 + th) + 128 * (arr & 1) + 32 * (dd >> 4) + 8 * ((dd >> 2) & 3) + 4 * (arr >> 1) + (dd & 3);
}
__device__ __forceinline__ int bt_row_gu(int c) { if (c < FFH) return 256 * (c >> 7) + (c & 127); const int j = c - FFH; return 256 * (j >> 7) + 128 + (j & 127); }

template <int MAP> __device__ __forceinline__ void p0_transpose_item(const float* W, int K, int N, bf16* WT, LAS float* scr, int item, int lane, const float* kscale = nullptr) {
    const int nblk = N / 32, kb = item / nblk, nb = item % nblk, k0 = 64 * kb, n0 = 32 * nb;
#pragma unroll 8
    for (int i = 0; i < 32; ++i) { const int kk = 2 * i + (lane >> 5); scr[kk * 33 + (lane & 31)] = W[(size_t)(k0 + kk) * N + n0 + (lane & 31)]; }
    asm volatile("s_waitcnt lgkmcnt(0)" ::: "memory");
    const int c = lane & 7;
    f32x4 ks0 = (f32x4){1.f, 1.f, 1.f, 1.f}, ks1 = ks0;
    if (kscale) { ks0 = *(const f32x4*)(kscale + k0 + 8 * c); ks1 = *(const f32x4*)(kscale + k0 + 8 * c + 4); }
#pragma unroll
    for (int j = 0; j < 4; ++j) { const int n = (lane >> 3) + 8 * j; const LAS float* s = scr + (8 * c) * 33 + n;
        u32x4 o; o.x = cvt_pk_bf16(s[0 * 33] * ks0[0], s[1 * 33] * ks0[1]); o.y = cvt_pk_bf16(s[2 * 33] * ks0[2], s[3 * 33] * ks0[3]); o.z = cvt_pk_bf16(s[4 * 33] * ks1[0], s[5 * 33] * ks1[1]); o.w = cvt_pk_bf16(s[6 * 33] * ks1[2], s[7 * 33] * ks1[3]);
        const int rr = (MAP == 1) ? bt_row_inproj(n0 + n) : (MAP == 2) ? bt_row_gu(n0 + n) : n0 + n;
        *(u32x4*)(WT + (size_t)rr * K + k0 + 8 * c) = o; }
    asm volatile("s_waitcnt lgkmcnt(0)" ::: "memory");
}
__device__ __forceinline__ float wave_sum(float v) {
#pragma unroll
    for (int o = 1; o < 64; o <<= 1) v += __shfl_xor(v, o);
    return v;
}

#define RLX_AGENT __ATOMIC_RELAXED, __HIP_MEMORY_SCOPE_AGENT
#define XB_TMO      128
#define XB_XCNT(j)  (256  + 64 * (j))
#define XB_XSUB(j)  (1280 + 64 * (j))
#define XB_XGEN(j)  (2304 + 64 * (j))
#define XB_TOP      3328
#define XB_TOPGEN   3392
#define XCD_BAR_WORDS 3456
#define XB_SPIN_CAP (1u << 18)

__device__ __forceinline__ unsigned xb_ld(unsigned* p)              { return __hip_atomic_load(p, __ATOMIC_RELAXED, __HIP_MEMORY_SCOPE_AGENT); }
__device__ __forceinline__ unsigned xb_add(unsigned* p, unsigned v) { return __hip_atomic_fetch_add(p, v, __ATOMIC_RELAXED, __HIP_MEMORY_SCOPE_AGENT); }
__device__ __forceinline__ unsigned xb_xcc_id() { return (unsigned)__builtin_amdgcn_s_getreg((3 << 11) | 20) & 0xFu; }
#define XB_SPIN(cond, bar) do { unsigned _sp = 0; while (cond) { __builtin_amdgcn_s_sleep(1); \
    if ((++_sp & 255u) == 0u) { if (xb_ld(&(bar)[XB_TMO])) break; if (_sp > XB_SPIN_CAP) { atomicAdd(&(bar)[XB_TMO], 1u); break; } } } } while (0)

struct XcdBarrier {
    unsigned* bar; unsigned x;
    volatile LAS unsigned* st;
};

__device__ __forceinline__ XcdBarrier xcd_barrier_post(unsigned* bar, volatile LAS unsigned* st) {
    XcdBarrier b; b.bar = bar; b.x = xb_xcc_id(); b.st = st;
    if (threadIdx.x == 0) (void)xb_add(&bar[XB_XCNT(b.x)], 1u);
    return b;
}
__device__ __forceinline__ void xcd_barrier_complete(unsigned* bar, unsigned x, unsigned& nloc, unsigned& nx) {
    const unsigned G = gridDim.x * gridDim.y * gridDim.z;
    unsigned sum, cnt, mine, sp = 0u;
    for (;;) {
        sum = 0u; cnt = 0u; mine = 0u;
#pragma unroll
        for (unsigned j = 0; j < 16; ++j) { const unsigned c = xb_ld(&bar[XB_XCNT(j)]); sum += c; cnt += (c > 0u) ? 1u : 0u; mine = (j == x) ? c : mine; }
        if (sum == G) break;
        __builtin_amdgcn_s_sleep(1);
        if ((++sp & 255u) == 0u) { if (xb_ld(&bar[XB_TMO])) break; if (sp > XB_SPIN_CAP) { atomicAdd(&bar[XB_TMO], 1u); break; } }
    }
    nloc = mine > 0u ? mine : 1u; nx = cnt > 0u ? cnt : 1u;
}

__device__ __forceinline__ void xcd_barrier(const XcdBarrier& b) {
    asm volatile("s_waitcnt vmcnt(0)" ::: "memory");
    __syncthreads();
    if (threadIdx.x == 0) {
        unsigned* bar = b.bar;
        __builtin_amdgcn_s_waitcnt(0);
        unsigned nloc = b.st[0], nx = b.st[1];
        if (nloc == 0u) { xcd_barrier_complete(bar, b.x, nloc, nx); b.st[0] = nloc; b.st[1] = nx; }
        const unsigned old = xb_add(&bar[XB_XSUB(b.x)], 1u);
        const unsigned gen = old / nloc;
        if (old + 1u == (gen + 1u) * nloc) {
            __builtin_amdgcn_fence(__ATOMIC_RELEASE, "agent");
            asm volatile("s_waitcnt vmcnt(0)" ::: "memory");
            const unsigned og = xb_add(&bar[XB_TOP], 1u);
            const unsigned tg = og / nx;
            if (og + 1u == (tg + 1u) * nx) xb_add(&bar[XB_TOPGEN], 1u);
            else XB_SPIN(xb_ld(&bar[XB_TOPGEN]) == tg, bar);
            __builtin_amdgcn_fence(__ATOMIC_ACQUIRE, "agent");
            xb_add(&bar[XB_XGEN(b.x)], 1u);
            asm volatile("s_waitcnt vmcnt(0)" ::: "memory");
        } else {
            XB_SPIN(xb_ld(&bar[XB_XGEN(b.x)]) == gen, bar);
            __builtin_amdgcn_fence(__ATOMIC_ACQUIRE, "agent");
            asm volatile("s_waitcnt vmcnt(0)" ::: "memory");
        }
    }
    __syncthreads();
}

struct Args { const float* in[10]; float* out; unsigned char* ws; };
__device__ __forceinline__ void prefetch_lines(const unsigned char* p, int nlines, int gt, int NGT) {
    for (int i = gt; i < nlines; i += NGT) { const unsigned v = *(const unsigned*)(p + (size_t)i * 128); asm volatile("" :: "v"(v)); }
}

__device__ __forceinline__ void p0_prologue(const Args& a, LAS unsigned char* lds, int gw, int NGW, int wave, int lane) {
    unsigned char* ws = a.ws;
    LAS float* scr = (LAS float*)(lds + wave * 16384);
    constexpr int I_IN = (DM / 64) * (NIN / 32);
    for (int it = gw; it < I_IN; it += NGW) p0_transpose_item<1>(a.in[2], DM, NIN, (bf16*)(ws + WS_WIN), scr, it, lane);
    const float* x = a.in[0]; const float* n1 = a.in[1]; bf16* XN = (bf16*)(ws + WS_XN);
    f32x4 nwv[4];
#pragma unroll
    for (int j = 0; j < 4; ++j) nwv[j] = *((const f32x4*)n1 + lane + 64 * j);
    for (int mi = gw; mi < M; mi += NGW) {
        const int m = (NGW == 2048) ? (2048 * ((mi >> 3) & 7) + 64 * ((mi >> 6) & 31) + 8 * (mi & 7) + (mi >> 11)) : mi;
        const f32x4* xr = (const f32x4*)(x + (size_t)m * DM) + lane; f32x4 v[4]; float s = 0.f;
#pragma unroll
        for (int j = 0; j < 4; ++j) { v[j] = xr[64 * j]; s += (v[j].x * v[j].x + v[j].y * v[j].y) + (v[j].z * v[j].z + v[j].w * v[j].w); }
        const float rs = 1.0f / sqrtf(wave_sum(s) * (1.0f / DM) + EPS);
        u32x2* o8 = (u32x2*)(XN + (size_t)m * DM) + lane;
#pragma unroll
        for (int j = 0; j < 4; ++j) { const f32x4 y = v[j] * rs * nwv[j]; u32x2 w; w.x = cvt_pk_bf16(y.x, y.y); w.y = cvt_pk_bf16(y.z, y.w); o8[64 * j] = w; }
    }
    if (gw == 0) { const float* ll = a.in[3]; float* lbt = (float*)(ws + WS_LB); for (int i = lane; i < 512; i += 64) lbt[i] = 1.0f / (1.0f + expf(ll[512 + i] - ll[i])); }
    const int gt = gw * 64 + lane, NGT = NGW * 64;
    float* rope = (float*)(ws + WS_ROPE);
    for (int i = gt; i < SEQ * 32; i += NGT) { const int t = i >> 5, k = i & 31; const float inv = powf(10000.0f, -(float)k / 32.0f); const float ang = (float)t * inv;
        rope[i] = cosf(ang); rope[SEQ * 32 + i] = sinf(ang); }
}

__device__ __forceinline__ void convert_rest(const Args& a, LAS unsigned char* lds, int gw2, int NGW2, int wave, int lane) {
    unsigned char* ws = a.ws;
    LAS float* scr = (LAS float*)(lds + wave * 16384);
    constexpr int I_OUT = (DM / 64) * (DM / 32), I_GU = (DM / 64) * (NGU / 32), I_DN = (FFH / 64) * (DM / 32);
    for (int it = gw2; it < I_OUT + I_GU + I_DN; it += NGW2) {
        int r = it;
        if (r < I_OUT) { p0_transpose_item<0>(a.in[5], DM, DM, (bf16*)(ws + WS_WOUT), scr, r, lane); continue; } r -= I_OUT;
        if (r < I_GU) { p0_transpose_item<2>(a.in[7], DM, NGU, (bf16*)(ws + WS_WGU), scr, r, lane, a.in[6]); continue; } r -= I_GU;
        p0_transpose_item<0>(a.in[8], FFH, DM, (bf16*)(ws + WS_WDN), scr, r, lane);
    }
}

constexpr int KPITCH = 144, KROWS = 384, VOFF = KROWS * KPITCH;
__device__ __forceinline__ int crow(int r, int hi) { return (r & 3) + 8 * (r >> 2) + 4 * hi; }
__device__ __forceinline__ s16x4 vtr(const LAS unsigned char* p) { typedef short v4i16_t __attribute__((ext_vector_type(4))); return __builtin_bit_cast(s16x4, __builtin_amdgcn_ds_read_tr16_b64_v4i16((LAS v4i16_t*)p)); }

struct AttnU { int pat, b, h, r, m0, dsh; };
__device__ __forceinline__ AttnU attn_decode(int unit) {
    AttnU U; U.pat = unit >> 9; const int rem = unit & 511, bh = rem >> 5, blk = rem & 31; U.b = bh >> 3; U.h = bh & 7;
    U.dsh = 2 * U.pat;
    const int bps = 32 >> U.dsh;
    U.r = blk / bps; U.m0 = 256 * (blk % bps); return U;
}
__device__ __forceinline__ void attn_load(const AttnU& U, unsigned char* ws, int tid, int wave, int lane, u32x4 (&kr)[6], u32x4 (&vr)[6], bf16x8 (&qf)[4]) {
    const bf16* Qg = (const bf16*)(ws + WS_Q) + (size_t)U.b * SEQ * 512 + U.h * 64;
    const bf16* Kg = (const bf16*)(ws + WS_K) + (size_t)U.b * SEQ * 512 + U.h * 64;
    const bf16* Vg = (const bf16*)(ws + WS_V) + (size_t)U.b * SEQ * 512 + U.h * 64;
#pragma unroll
    for (int it = 0; it < 6; ++it) {
        const int i = tid + it * NTHR; const int row = i >> 3, ch = i & 7; const int mk = U.m0 - 128 + row;
        kr[it] = (u32x4){0u, 0u, 0u, 0u}; vr[it] = (u32x4){0u, 0u, 0u, 0u};
        if (mk >= 0) { const unsigned off = (unsigned)((mk << U.dsh) + U.r) * 512u + (unsigned)(ch * 8); kr[it] = *(const u32x4*)(Kg + off); vr[it] = *(const u32x4*)(Vg + off); }
    }
    const int ql = lane & 31, hi = lane >> 5; const int mq = U.m0 + 32 * wave + ql; const unsigned tq = (unsigned)((mq << U.dsh) + U.r);
#pragma unroll
    for (int kk = 0; kk < 4; ++kk) qf[kk] = *(const bf16x8*)(Qg + tq * 512u + (unsigned)(16 * kk + 8 * hi));
}
__device__ __forceinline__ void attn_stage(LAS unsigned char* lds, int tid, const u32x4 (&kr)[6], const u32x4 (&vr)[6]) {
#pragma unroll
    for (int it = 0; it < 6; ++it) { const int i = tid + it * NTHR; const int row = i >> 3, ch = i & 7;
        *(LAS u32x4*)(lds + row * KPITCH + ch * 16) = kr[it]; *(LAS u32x4*)(lds + VOFF + row * KPITCH + ch * 16) = vr[it]; }
}
__device__ __forceinline__ void attn_compute(const AttnU& U, LAS unsigned char* lds, unsigned char* ws, int wave, int lane, const bf16x8 (&qf)[4]) {
    const int pat = U.pat, m0 = U.m0, dsh = U.dsh, r = U.r;
    bf16* Og = (bf16*)(ws + (pat == 0 ? WS_OP0 : pat == 1 ? WS_OP1 : WS_OP2)) + (size_t)U.b * SEQ * 512 + U.h * 64;
    float* Lg = (float*)(ws + WS_LSE) + ((size_t)(pat * 16 + U.b * 8 + U.h) * SEQ + (size_t)r * (SEQ >> dsh));
    const int ql = lane & 31, hi = lane >> 5;
    const int mq = m0 + 32 * wave + ql; const size_t tq = (size_t)((mq << dsh) + r);
    f32x16 st[5];
#pragma unroll
    for (int kt = 0; kt < 5; ++kt) {
        st[kt] = (f32x16){};
        const LAS unsigned char* kp = lds + (32 * wave + 32 * kt + ql) * KPITCH + 16 * hi;
#pragma unroll
        for (int kk = 0; kk < 4; ++kk) { const bf16x8 kf = *(const LAS bf16x8*)(kp + 32 * kk); st[kt] = __builtin_amdgcn_mfma_f32_32x32x16_bf16(kf, qf[kk], st[kt], 0, 0, 0); }
    }
    const float NEG = -1e30f; float mx = NEG;
#pragma unroll
    for (int kt = 0; kt < 5; ++kt)
#pragma unroll
        for (int i = 0; i < 16; ++i) {
            const int cr = crow(i, hi); const int R = 32 * wave + 32 * kt + cr;
            bool ok = (m0 - 128 + R) >= 0;
            if (kt == 0) ok = ok && (cr >= ql);
            if (kt == 4) ok = ok && (cr <= ql);
            const float s = ok ? st[kt][i] : NEG; st[kt][i] = s; mx = fmaxf(mx, s);
        }
    mx = fmaxf(mx, __shfl_xor(mx, 32));
    float lsum = 0.f;
#pragma unroll
    for (int kt = 0; kt < 5; ++kt)
#pragma unroll
        for (int i = 0; i < 16; ++i) { const float p = __builtin_amdgcn_exp2f(st[kt][i] - mx); st[kt][i] = p; lsum += p; }
    lsum += __shfl_xor(lsum, 32);
    f32x16 o[2]; o[0] = (f32x16){}; o[1] = (f32x16){};
    const int blk16 = (lane >> 4) & 1, q4 = (lane & 15) >> 2, p4 = lane & 3;
    const LAS unsigned char* vbase = lds + VOFF + (32 * wave + 4 * hi + q4) * KPITCH + (16 * blk16 + 4 * p4) * 2;
#pragma unroll
    for (int kt = 0; kt < 5; ++kt)
#pragma unroll
        for (int ks = 0; ks < 2; ++ks) {
            u32x4 pw; pw.x = cvt_pk_bf16(st[kt][8 * ks + 0], st[kt][8 * ks + 1]); pw.y = cvt_pk_bf16(st[kt][8 * ks + 2], st[kt][8 * ks + 3]);
            pw.z = cvt_pk_bf16(st[kt][8 * ks + 4], st[kt][8 * ks + 5]); pw.w = cvt_pk_bf16(st[kt][8 * ks + 6], st[kt][8 * ks + 7]);
            const bf16x8 pb = __builtin_bit_cast(bf16x8, pw);
#pragma unroll
            for (int c = 0; c < 2; ++c) {
                const LAS unsigned char* vp = vbase + (32 * kt + 16 * ks) * KPITCH + 64 * c;
                const s16x4 v0 = vtr(vp), v1 = vtr(vp + 8 * KPITCH);
                const bf16x8 va = (bf16x8){v0[0], v0[1], v0[2], v0[3], v1[0], v1[1], v1[2], v1[3]};
                o[c] = __builtin_amdgcn_mfma_f32_32x32x16_bf16(va, pb, o[c], 0, 0, 0);
            }
        }
    const float rl = 1.0f / lsum;
    bf16* orow = Og + tq * 512;
#pragma unroll
    for (int c = 0; c < 2; ++c)
#pragma unroll
        for (int j = 0; j < 2; ++j) {
            const int g0 = 2 * j, g1 = 2 * j + 1;
            const unsigned a0 = cvt_pk_bf16(o[c][4 * g0] * rl, o[c][4 * g0 + 1] * rl), a1 = cvt_pk_bf16(o[c][4 * g0 + 2] * rl, o[c][4 * g0 + 3] * rl);
            const unsigned b0 = cvt_pk_bf16(o[c][4 * g1] * rl, o[c][4 * g1 + 1] * rl), b1 = cvt_pk_bf16(o[c][4 * g1 + 2] * rl, o[c][4 * g1 + 3] * rl);
            const auto sx = __builtin_amdgcn_permlane32_swap(a0, b0, false, false), sy = __builtin_amdgcn_permlane32_swap(a1, b1, false, false);
            u32x4 w; w.x = sx[0]; w.y = sy[0]; w.z = sx[1]; w.w = sy[1];
            *(u32x4*)(orow + 32 * c + 16 * j + 8 * hi) = w;
        }
    if (hi == 0) Lg[mq] = mx + __builtin_amdgcn_logf(lsum);
}
__device__ __forceinline__ void attn_phase(LAS unsigned char* lds, unsigned char* ws, int bx, int G, int tid, int wave, int lane) {
    u32x4 kr[6], vr[6]; bf16x8 qn[4], qc[4];
    int u = (G % 8 == 0) ? (bx & 7) * (G >> 3) + (bx >> 3) : bx;
    if (u >= 1536) return;
    AttnU U = attn_decode(u); attn_load(U, ws, tid, wave, lane, kr, vr, qn);
    for (; u < 1536; u += G) {
        attn_stage(lds, tid, kr, vr);
#pragma unroll
        for (int kk = 0; kk < 4; ++kk) qc[kk] = qn[kk];
        __syncthreads();
        const AttnU Uc = U; const int un = u + G;
        if (un < 1536) { U = attn_decode(un); attn_load(U, ws, tid, wave, lane, kr, vr, qn); }
        attn_compute(Uc, lds, ws, wave, lane, qc);
        __syncthreads();
    }
}

__device__ __forceinline__ int psi(int j, int c) { return 32 * (j >> 1) + 8 * (c >> 2) + 4 * (j & 1) + (c & 3); }
__device__ __forceinline__ int kut_lds_off(int p) { const int dk = p >> 1; const int j = 2 * (dk >> 5) + ((dk >> 2) & 1), c = 4 * ((dk >> 3) & 3) + (dk & 3), g0 = 2 * (p & 1); return ((j * 4 + g0) * 16 + c) * 8; }

constexpr int P1_VT_OFF = 65536, P1_DEC_OFF = 131072;
__device__ __forceinline__ void hgrn_pass1(int item, LAS unsigned char* lds, unsigned char* ws, int tid, int wave, int lane) {
    const int seq = item >> 5, sc = item & 31, b = seq >> 2, h = seq & 3; const int g = lane >> 4, c = lane & 15;
    const int chunk0 = (b * SEQ + sc * 256) >> 4;
    const bf16* KUT = (const bf16*)(ws + WS_KUT); const bf16* VT = (const bf16*)(ws + WS_VT); const float* DEC = (const float*)(ws + WS_DEC);
    u32x4 st[8], sv[8];
#pragma unroll
    for (int it = 0; it < 8; ++it) { const int idx = tid + NTHR * it; const int ck = idx >> 8, p = idx & 255; const size_t go = ((size_t)(chunk0 + ck) * 512 + h * 128) * 16 + p * 8;
        st[it] = *(const u32x4*)(KUT + go); sv[it] = *(const u32x4*)(VT + go); }
    const f32x4 sd = *(const f32x4*)(DEC + (size_t)(chunk0 + (tid >> 5)) * 512 + h * 128 + 4 * (tid & 31));
#pragma unroll
    for (int it = 0; it < 8; ++it) { const int idx = tid + NTHR * it; const int ck = idx >> 8, p = idx & 255; LAS unsigned char* d = lds + ck * 4096 + kut_lds_off(p);
        *(LAS u32x2*)d = (u32x2){st[it].x, st[it].y}; *(LAS u32x2*)(d + 128) = (u32x2){st[it].z, st[it].w};
        *(LAS u32x4*)(lds + P1_VT_OFF + idx * 16) = sv[it]; }
    *(LAS f32x4*)(lds + P1_DEC_OFF + tid * 16) = sd;
    __syncthreads();
    f32x4 S[8], dt[8];
#pragma unroll
    for (int j = 0; j < 8; ++j) { S[j] = (f32x4){0.f, 0.f, 0.f, 0.f}; dt[j] = (f32x4){1.f, 1.f, 1.f, 1.f}; }
#pragma unroll 2
    for (int ck = 0; ck < 16; ++ck) {
        const s16x4 vb = *(const LAS s16x4*)(lds + P1_VT_OFF + ck * 4096 + ((16 * wave + c) * 16 + 4 * g) * 2);
#pragma unroll
        for (int j = 0; j < 8; ++j) {
            const s16x4 ka = *(const LAS s16x4*)(lds + ck * 4096 + ((j * 4 + g) * 16 + c) * 8);
            const f32x4 dc = *(const LAS f32x4*)(lds + P1_DEC_OFF + (ck * 128 + 32 * (j >> 1) + 8 * g + 4 * (j & 1)) * 4);
            S[j] = __builtin_amdgcn_mfma_f32_16x16x16bf16_1k(ka, vb, S[j] * dc, 0, 0, 0); dt[j] = dt[j] * dc;
        }
    }
    bf16* U = (bf16*)(ws + WS_U) + (size_t)item * 16384;
#pragma unroll
    for (int j = 0; j < 8; ++j) { u32x2 w; w.x = cvt_pk_bf16(S[j][0], S[j][1]); w.y = cvt_pk_bf16(S[j][2], S[j][3]); *(u32x2*)(U + ((wave * 8 + j) * 64 + lane) * 4) = w; }
    if (wave == 0 && c == 0) { float* D = (float*)(ws + WS_DTOT) + item * 128;
#pragma unroll
        for (int j = 0; j < 8; ++j) *(f32x4*)(D + 32 * (j >> 1) + 8 * g + 4 * (j & 1)) = dt[j]; }
    __syncthreads();
}

constexpr int OPITCH = 132, P3_QI = 16384, P3_KX = 32768, P3_VT = 49152, P3_DEC = 65536, P3_OT = 67584;
__device__ __forceinline__ void hgrn_pass3(int item, LAS unsigned char* lds, unsigned char* ws, const float* nw, int tid, int wave, int lane) {
    const int seq = item >> 5, sc = item & 31, b = seq >> 2, h = seq & 3; const int g = lane >> 4, c = lane & 15;
    const int tok0 = b * SEQ + sc * 256; const int chunk0 = tok0 >> 4;
    const bf16* KUT = (const bf16*)(ws + WS_KUT); const bf16* VT = (const bf16*)(ws + WS_VT); const float* DEC = (const float*)(ws + WS_DEC);
    const bf16* QI = (const bf16*)(ws + WS_QI); const bf16* GS = (const bf16*)(ws + WS_GS);
    bf16* MIX = (bf16*)(ws + WS_MIX);
    LAS float* ot = (LAS float*)(lds + P3_OT);
    f32x4 S[8];
    {
        const bf16* Ub = (const bf16*)(ws + WS_U) + (size_t)(seq * 32) * 16384 + (size_t)(wave * 8 * 64 + lane) * 4;
        const float* Db = (const float*)(ws + WS_DTOT) + (size_t)(seq * 32) * 128 + 8 * g;
        f32x4 W[8];
#pragma unroll
        for (int j = 0; j < 8; ++j) { S[j] = (f32x4){0.f, 0.f, 0.f, 0.f}; W[j] = (f32x4){1.f, 1.f, 1.f, 1.f}; }
        for (int k = sc - 1; k >= 0; k -= 2) {
            const int k2 = k > 0 ? k - 1 : 0;
            f32x4 u[8], d[8], u2[8], d2[8];
#pragma unroll
            for (int j = 0; j < 8; ++j) { const u32x2 a_ = *(const u32x2*)(Ub + (size_t)k * 16384 + j * 256), b_ = *(const u32x2*)(Ub + (size_t)k2 * 16384 + j * 256);
                u[j] = (f32x4){__uint_as_float(a_.x << 16), __uint_as_float(a_.x & 0xffff0000u), __uint_as_float(a_.y << 16), __uint_as_float(a_.y & 0xffff0000u)};
                u2[j] = (f32x4){__uint_as_float(b_.x << 16), __uint_as_float(b_.x & 0xffff0000u), __uint_as_float(b_.y << 16), __uint_as_float(b_.y & 0xffff0000u)};
                d[j] = *(const f32x4*)(Db + k * 128 + 32 * (j >> 1) + 4 * (j & 1)); d2[j] = *(const f32x4*)(Db + k2 * 128 + 32 * (j >> 1) + 4 * (j & 1)); }
            float live = 0.f;
#pragma unroll
            for (int j = 0; j < 8; ++j) { S[j] += W[j] * u[j]; W[j] = W[j] * d[j]; if (k > 0) { S[j] += W[j] * u2[j]; W[j] = W[j] * d2[j]; } live += (W[j][0] + W[j][1]) + (W[j][2] + W[j][3]); }
            if (!__any(live != 0.f)) break;
        }
    }
    const f32x4 n0 = *(const f32x4*)(nw + h * 128 + (tid & 15) * 8), n1 = *(const f32x4*)(nw + h * 128 + (tid & 15) * 8 + 4);
    u32x4 s_kut[2], s_vt[2], s_qi[2], s_gs[2]; float s_dinv[2]; f32x4 s_dec = (f32x4){0.f, 0.f, 0.f, 0.f};
#define P3_LOAD(q) do { \
        _Pragma("unroll") for (int it = 0; it < 2; ++it) { const int idx = tid + NTHR * it; const int ckl = idx >> 8, p = idx & 255; const int ckg = chunk0 + 4 * (q) + ckl; \
            s_kut[it] = *(const u32x4*)(KUT + ((size_t)ckg * 512 + h * 128) * 16 + p * 8); s_vt[it] = *(const u32x4*)(VT + ((size_t)ckg * 512 + h * 128) * 16 + p * 8); \
            const size_t to = (size_t)(ckg * 16 + (p >> 4)) * 512 + h * 128 + (p & 15) * 8; s_qi[it] = *(const u32x4*)(QI + to); s_dinv[it] = 1.0f / DEC[(size_t)ckg * 512 + h * 128 + (p >> 1)]; \
            s_gs[it] = *(const u32x4*)(GS + (size_t)(tok0 + 64 * (q) + (idx >> 4)) * 512 + h * 128 + (idx & 15) * 8); } \
        if (tid < 128) s_dec = *(const f32x4*)(DEC + (size_t)(chunk0 + 4 * (q) + (tid >> 5)) * 512 + h * 128 + 4 * (tid & 31)); \
    } while (0)
    P3_LOAD(0);
    for (int q = 0; q < 4; ++q) {
#pragma unroll
        for (int it = 0; it < 2; ++it) { const int idx = tid + NTHR * it; const int ckl = idx >> 8, p = idx & 255;
            LAS unsigned char* d = lds + ckl * 4096 + kut_lds_off(p);
            *(LAS u32x2*)d = (u32x2){s_kut[it].x, s_kut[it].y}; *(LAS u32x2*)(d + 128) = (u32x2){s_kut[it].z, s_kut[it].w};
            const int tl = p >> 4, dg = p & 15; const int fo = ckl * 4096 + (((dg >> 2) * 4 + (dg & 3)) * 16 + tl) * 16;
            *(LAS u32x4*)(lds + P3_QI + fo) = s_qi[it]; *(LAS u32x4*)(lds + P3_VT + idx * 16) = s_vt[it];
            { const int d = p >> 1; LAS unsigned char* kb = lds + P3_KX + ckl * 4096 + ((d >> 3) * 16 + 8 * (p & 1)) * 16 + (d & 7) * 2; const float di = s_dinv[it];
#pragma unroll
              for (int e8 = 0; e8 < 8; ++e8) { const unsigned wv = s_kut[it][e8 >> 1]; const float kuv = __uint_as_float((e8 & 1) ? (wv & 0xffff0000u) : (wv << 16));
                  *(LAS unsigned short*)(kb + e8 * 16) = cvt_bf16(kuv * di); } } }
        if (tid < 128) *(LAS f32x4*)(lds + P3_DEC + tid * 16) = s_dec;
        u32x4 gsc[2];
        gsc[0] = s_gs[0]; gsc[1] = s_gs[1];
        __syncthreads();
        if (q < 3) P3_LOAD(q + 1);
#pragma unroll 1
        for (int ckl = 0; ckl < 4; ++ckl) {
            const s16x4 vbc = *(const LAS s16x4*)(lds + P3_VT + ckl * 4096 + ((16 * wave + c) * 16 + 4 * g) * 2);
            bf16x8 kxf[4], qif[4];
#pragma unroll
            for (int kk = 0; kk < 4; ++kk) { const int fo = ckl * 4096 + ((kk * 4 + g) * 16 + c) * 16; kxf[kk] = *(const LAS bf16x8*)(lds + P3_KX + fo); qif[kk] = *(const LAS bf16x8*)(lds + P3_QI + fo); }
            f32x4 pt = (f32x4){0.f, 0.f, 0.f, 0.f};
#pragma unroll
            for (int kk = 0; kk < 4; ++kk) pt = __builtin_amdgcn_mfma_f32_16x16x32_bf16(kxf[kk], qif[kk], pt, 0, 0, 0);
#pragma unroll
            for (int i = 0; i < 4; ++i) if (4 * g + i > c) pt[i] = 0.f;
            u32x2 pw; pw.x = cvt_pk_bf16(pt[0], pt[1]); pw.y = cvt_pk_bf16(pt[2], pt[3]);
            f32x4 o0 = __builtin_amdgcn_mfma_f32_16x16x16bf16_1k(__builtin_bit_cast(s16x4, pw), vbc, (f32x4){0.f, 0.f, 0.f, 0.f}, 0, 0, 0);
            f32x4 o1 = (f32x4){0.f, 0.f, 0.f, 0.f};
#pragma unroll
            for (int j = 0; j < 8; ++j) {
                const bf16x8 qq = qif[j >> 1];
                const s16x4 qa = (j & 1) ? (s16x4){qq[4], qq[5], qq[6], qq[7]} : (s16x4){qq[0], qq[1], qq[2], qq[3]};
                u32x2 sw; sw.x = cvt_pk_bf16(S[j][0], S[j][1]); sw.y = cvt_pk_bf16(S[j][2], S[j][3]);
                if (j & 1) o1 = __builtin_amdgcn_mfma_f32_16x16x16bf16_1k(qa, __builtin_bit_cast(s16x4, sw), o1, 0, 0, 0);
                else       o0 = __builtin_amdgcn_mfma_f32_16x16x16bf16_1k(qa, __builtin_bit_cast(s16x4, sw), o0, 0, 0, 0);
            }
#pragma unroll
            for (int j = 0; j < 8; ++j) {
                const s16x4 ka = *(const LAS s16x4*)(lds + ckl * 4096 + ((j * 4 + g) * 16 + c) * 8);
                const f32x4 dc = *(const LAS f32x4*)(lds + P3_DEC + (ckl * 128 + 32 * (j >> 1) + 8 * g + 4 * (j & 1)) * 4);
                S[j] = __builtin_amdgcn_mfma_f32_16x16x16bf16_1k(ka, vbc, S[j] * dc, 0, 0, 0);
            }
            const f32x4 o = o0 + o1;
            LAS float* op = ot + (ckl * 16 + 4 * g) * OPITCH + 16 * wave + c;
#pragma unroll
            for (int i = 0; i < 4; ++i) op[i * OPITCH] = o[i];
        }
        __syncthreads();
#pragma unroll
        for (int it = 0; it < 2; ++it) {
            const int idx = tid + NTHR * it; const int tl = idx >> 4, d8 = (idx & 15) * 8; const int tok = tok0 + q * 64 + tl;
            const f32x4 v0 = *(const LAS f32x4*)(ot + tl * OPITCH + d8), v1 = *(const LAS f32x4*)(ot + tl * OPITCH + d8 + 4);
            const u32x4 gq = gsc[it];
            float ss = (v0[0] * v0[0] + v0[1] * v0[1]) + (v0[2] * v0[2] + v0[3] * v0[3]) + (v1[0] * v1[0] + v1[1] * v1[1]) + (v1[2] * v1[2] + v1[3] * v1[3]);
            ss += __shfl_xor(ss, 1); ss += __shfl_xor(ss, 2); ss += __shfl_xor(ss, 4); ss += __shfl_xor(ss, 8);
            const float rs = __builtin_amdgcn_rsqf(ss * (1.0f / 128.0f) + EPS);
            f32x4 y0 = v0 * rs * n0, y1 = v1 * rs * n1;
            y0[0] *= __uint_as_float(gq[0] << 16); y0[1] *= __uint_as_float(gq[0] & 0xffff0000u); y0[2] *= __uint_as_float(gq[1] << 16); y0[3] *= __uint_as_float(gq[1] & 0xffff0000u);
            y1[0] *= __uint_as_float(gq[2] << 16); y1[1] *= __uint_as_float(gq[2] & 0xffff0000u); y1[2] *= __uint_as_float(gq[3] << 16); y1[3] *= __uint_as_float(gq[3] & 0xffff0000u);
            u32x4 w; w.x = cvt_pk_bf16(y0[0], y0[1]); w.y = cvt_pk_bf16(y0[2], y0[3]); w.z = cvt_pk_bf16(y1[0], y1[1]); w.w = cvt_pk_bf16(y1[2], y1[3]);
            *(u32x4*)(MIX + (size_t)tok * 1024 + 512 + h * 128 + d8) = w;
        }
    }
    __syncthreads();
#undef P3_LOAD
}

__device__ __forceinline__ int affine_item(int c) { const int pm = 8 * (c & 7) + ((c >> 3) & 7), h = c >> 6; return (((pm >> 5) * 4 + h) << 5) + (pm & 31); }
__device__ __forceinline__ void attn_merge(unsigned char* ws, int gt, int NGT) {
    const bool aff = (NGT == 256 * NTHR); const int c_ = gt / NTHR, tl_ = gt % NTHR; const int tokb_ = 256 * (8 * (c_ & 7) + ((c_ >> 3) & 7)) + 64 * (c_ >> 6);
    const float* L = (const float*)(ws + WS_LSE); bf16* MIX = (bf16*)(ws + WS_MIX);
    const bf16* O0 = (const bf16*)(ws + WS_OP0); const bf16* O1 = (const bf16*)(ws + WS_OP1); const bf16* O2 = (const bf16*)(ws + WS_OP2);
    for (int idx = gt; idx < M * 64; idx += NGT) {
        const int k_ = idx / NGT, il_ = tl_ + NTHR * k_;
        const int tok = aff ? tokb_ + (il_ >> 6) : idx >> 6, hh = aff ? (il_ >> 3) & 7 : (idx >> 3) & 7, ch = aff ? il_ & 7 : idx & 7;
        const int bb = tok >> 13, tt = tok & (SEQ - 1); const size_t hb = (size_t)(bb * 8 + hh) * SEQ;
        const float l0 = L[hb + tt], l1 = L[(size_t)16 * SEQ + hb + (size_t)(tt & 3) * (SEQ >> 2) + (tt >> 2)], l2 = L[(size_t)32 * SEQ + hb + (size_t)(tt & 15) * (SEQ >> 4) + (tt >> 4)];
        const float mx = fmaxf(l0, fmaxf(l1, l2));
        float w0 = __builtin_amdgcn_exp2f(l0 - mx), w1 = __builtin_amdgcn_exp2f(l1 - mx), w2 = __builtin_amdgcn_exp2f(l2 - mx);
        const float inv = 1.0f / (w0 + w1 + w2); w0 *= inv; w1 *= inv; w2 *= inv;
        const size_t off = (size_t)tok * 512 + hh * 64 + ch * 8;
        const u32x4 a = *(const u32x4*)(O0 + off), bq = *(const u32x4*)(O1 + off), cq = *(const u32x4*)(O2 + off);
        u32x4 r;
#pragma unroll
        for (int k = 0; k < 4; ++k) {
            const float lo = w0 * __uint_as_float(a[k] << 16) + w1 * __uint_as_float(bq[k] << 16) + w2 * __uint_as_float(cq[k] << 16);
            const float hi = w0 * __uint_as_float(a[k] & 0xffff0000u) + w1 * __uint_as_float(bq[k] & 0xffff0000u) + w2 * __uint_as_float(cq[k] & 0xffff0000u);
            r[k] = cvt_pk_bf16(lo, hi);
        }
        *(u32x4*)(MIX + (size_t)tok * 1024 + hh * 64 + ch * 8) = r;
    }
}

__global__ void __launch_bounds__(NTHR, 2) fwd_megakernel(Args args) {
    extern __shared__ __attribute__((aligned(16))) unsigned char lds_raw[];
    LAS unsigned char* lds = (LAS unsigned char*)lds_raw;
    const int G = gridDim.x, bx = blockIdx.x;
    const int NGW = G * NWAVES, NGT = G * NTHR;
    unsigned char* ws = args.ws;
    volatile LAS unsigned* MISC = (volatile LAS unsigned*)(lds + LDS_BYTES - 128);
    if (threadIdx.x < 32) MISC[threadIdx.x] = 0u;
    __syncthreads();
    const XcdBarrier bar = xcd_barrier_post((unsigned*)(ws + WS_BAR), MISC + 8);
#define GRID_SYNC() xcd_barrier(bar)
#define PHASE_IDS() int tid = threadIdx.x; asm volatile("" : "+v"(tid)); const int lane = tid & 63, wave = __builtin_amdgcn_readfirstlane(tid >> 6); const int gw = bx * NWAVES + wave, gt = bx * NTHR + tid; (void)lane; (void)gw; (void)gt

    { PHASE_IDS(); p0_prologue(args, lds, gw, NGW, wave, lane);
    }
    GRID_SYNC();
    {
        pg8::Gemm g{(const pg8::bf16_t*)(ws + WS_XN), (const pg8::bf16_t*)(ws + WS_WIN), M, NIN, DM}; pg8::StaticOrder S; S.init(M, NIN, G, bx);
        pg8::EpiInProj E{ws};
        pg8::gemm_phase<pg8::EpiInProj, pg8::StaticOrder, true, true>(lds, g, S, E);
        if (bx >= 128) { PHASE_IDS(); convert_rest(args, lds, (bx - 128) * NWAVES + wave, (G - 128) * NWAVES, wave, lane); }
    }
    GRID_SYNC();
    { PHASE_IDS(); for (int it = bx; it < 256; it += G) hgrn_pass1(affine_item(it), lds, ws, tid, wave, lane);
    }
    { PHASE_IDS(); attn_phase(lds, ws, bx, G, tid, wave, lane);
    }
    GRID_SYNC();
    { PHASE_IDS(); for (int it = bx; it < 256; it += G) hgrn_pass3(affine_item(it), lds, ws, args.in[4], tid, wave, lane);
    }
    { PHASE_IDS(); attn_merge(ws, gt, NGT);
    }
    GRID_SYNC();
    {
        pg8::Gemm g{(const pg8::bf16_t*)(ws + WS_MIX), (const pg8::bf16_t*)(ws + WS_WOUT), M, DM, DM}; pg8::StaticOrder S; S.init(M, DM, G, bx);
        pg8::EpiOutProj E{args.in[0], (bf16*)(ws + WS_Q), (float*)(ws + WS_SS1)};
        pg8::gemm_phase<pg8::EpiOutProj, pg8::StaticOrder, true, true>(lds, g, S, E);
        { PHASE_IDS(); prefetch_lines(ws + WS_WGU, (NGU * DM * 2) / 128, gt, NGT); }
    }
    GRID_SYNC();
    {
        pg8::Gemm g{(const pg8::bf16_t*)(ws + WS_Q), (const pg8::bf16_t*)(ws + WS_WGU), M, NGU, DM}; pg8::StaticOrder S; S.init(M, NGU, G, bx);
        pg8::EpiGateUp E{(bf16*)(ws + WS_ACT), (const float*)(ws + WS_SS1)};
        pg8::gemm_phase<pg8::EpiGateUp, pg8::StaticOrder, true, true>(lds, g, S, E);
        { PHASE_IDS(); prefetch_lines(ws + WS_WDN, (DM * FFH * 2) / 128, gt, NGT); }
    }
    GRID_SYNC();
    {
        pg8::Gemm g{(const pg8::bf16_t*)(ws + WS_ACT), (const pg8::bf16_t*)(ws + WS_WDN), M, DM, FFH}; pg8::StaticOrder S; S.init(M, DM, G, bx);
        pg8::EpiDownNorm E{(const bf16*)(ws + WS_Q), args.out, (float*)(ws + WS_SS2), (unsigned*)(ws + WS_PCNT), args.in[9]};
        pg8::gemm_phase<pg8::EpiDownNorm, pg8::StaticOrder, false, true>(lds, g, S, E);
    }
}

extern "C" void kernel_launch(void* const* d_in, const int* in_sizes, int n_in, void* d_out, int out_size, void* d_ws, size_t ws_size, hipStream_t stream) {
    static int grid = 0;
    if (grid == 0) {
        if (n_in != 10 || in_sizes[0] != M * DM || out_size != M * DM || ws_size < WS_END) { fprintf(stderr, "kernel_launch: unexpected shapes (n_in %d in0 %d out %d ws %zu)\n", n_in, n_in > 0 ? in_sizes[0] : -1, out_size, ws_size); grid = -1; return; }
        int dev = 0, cus = 0, per_cu = 0;
        hipGetDevice(&dev); hipDeviceGetAttribute(&cus, hipDeviceAttributeMultiprocessorCount, dev);
        hipFuncSetAttribute((const void*)fwd_megakernel, hipFuncAttributeMaxDynamicSharedMemorySize, LDS_BYTES);
        hipOccupancyMaxActiveBlocksPerMultiprocessor(&per_cu, (const void*)fwd_megakernel, NTHR, LDS_BYTES);
        if (per_cu < 1) { fprintf(stderr, "kernel_launch: occupancy query says %d blocks per CU; nothing launched\n", per_cu); grid = -1; return; }
        (void)hipGetLastError();
        grid = cus * 1;
        if (grid != 256) { fprintf(stderr, "kernel_launch: this kernel needs exactly 256 CUs (got %d)\n", cus); grid = -1; return; }
    }
    if (grid < 0) return;
    if (hipMemsetAsync(d_ws, 0, WS_ZERO_BYTES, stream) != hipSuccess) { fprintf(stderr, "kernel_launch: memset failed\n"); return; }
    Args a{};
    for (int i = 0; i < 10; ++i) a.in[i] = (const float*)d_in[i];
    a.out = (float*)d_out; a.ws = (unsigned char*)d_ws;
    void* kargs[] = {&a};
    hipError_t e = hipLaunchCooperativeKernel((const void*)fwd_megakernel, dim3(grid), dim3(NTHR), kargs, LDS_BYTES, stream);
    if (e != hipSuccess) fprintf(stderr, "cooperative launch failed: %s (grid %d)\n", hipGetErrorString(e), grid);
}
```

```cpp
#include <hip/hip_runtime.h>
#include <cstdio>
#include <cstdint>
constexpr int SEQ = 8192, DM = 1024, M = 2 * SEQ, NIN = 3584, FFH = 2816, NGU = 2 * FFH;
constexpr float EPS = 1e-6f;
constexpr int NWAVES = 8, NTHR = 512;
constexpr size_t MiB = 1u << 20;
constexpr size_t WS_SS1 = 0, WS_SS2 = 65536;
constexpr size_t WS_BAR = 131072;
constexpr size_t WS_ZERO_BYTES = 163840;
constexpr size_t WS_DTOT = 262144;
constexpr size_t WS_LB = 393216;
constexpr size_t WS_PCNT = 147456;
constexpr size_t WS_RSINV = 409600;
constexpr size_t WS_WIN = MiB / 2;
constexpr size_t WS_WOUT = WS_WIN + 7 * MiB;
constexpr size_t WS_WGU = WS_WOUT + 2 * MiB;
constexpr size_t WS_WDN = WS_WGU + 11 * MiB;
constexpr size_t WS_ROPE = WS_WDN + 11 * MiB / 2;
constexpr size_t WS_DEC = WS_ROPE + 2 * MiB;
constexpr size_t WS_LSE = WS_DEC + 2 * MiB;
static_assert(WS_LSE + 3 * MiB / 2 <= 32 * MiB, "region A");
constexpr size_t WS_XN = 32 * MiB;
constexpr size_t WS_OP0 = 32 * MiB, WS_OP1 = 48 * MiB;
constexpr size_t WS_MIX = 64 * MiB;
constexpr size_t WS_Q = 96 * MiB, WS_K = 112 * MiB, WS_V = 128 * MiB, WS_OP2 = 144 * MiB;
constexpr size_t WS_QI = 160 * MiB, WS_KX = 176 * MiB, WS_KUT = 192 * MiB, WS_VT = 208 * MiB, WS_GS = 224 * MiB, WS_U = 240 * MiB;
constexpr size_t WS_ACT = 160 * MiB;
constexpr size_t WS_END = 256 * MiB;
namespace pg8 {
#define PG8_LAS __attribute__((address_space(3)))
typedef unsigned short bf16_t;
typedef short bf16x8 __attribute__((ext_vector_type(8)));
typedef float f32x4 __attribute__((ext_vector_type(4)));
typedef unsigned u32x4 __attribute__((ext_vector_type(4))); typedef unsigned u32x2 __attribute__((ext_vector_type(2)));
constexpr int BM = 256, BK = 64, HALF = 128, HTB = HALF * BK * 2  , STAGE_BYTES = 8 * HTB, NXCD = 8, WGM = 8;

__host__ __device__ __forceinline__ int lds_byte(int r, int c) { const int st = (r >> 4) * 2 + (c >> 5), rr = r & 15, cc = c & 31, ob = rr * 64 + cc * 2; return st * 1024 + (ob ^ (((ob >> 9) & 1) << 5)); }
__host__ __device__ __forceinline__ void stage_rc(int b, int& R, int& C) { const int st = b / 1024, sb = b % 1024, swz = sb ^ (((sb >> 9) & 1) << 5); R = (st >> 1) * 16 + swz / 64; C = (st & 1) * 32 + (swz % 64) / 2; }
__host__ __device__ __forceinline__ int perm32(int rho) { const int n = rho >> 4, i = rho & 15; return 8 * (i >> 2) + 4 * n + (i & 3); }

struct Unit { int pm, pn; };
struct Gemm { const bf16_t* A; const bf16_t* Bt; int M, N, K; };

struct StaticOrder {
    int nM, nN, nwg, G, c;
    __host__ __device__ void init(int M, int N, int G_, int c_) { nM = M / BM; nN = N / BM; nwg = nM * nN; G = G_; c = c_; }
    __host__ __device__ bool next(int i, Unit& u) const {
        const long L = (long)i * G + c; if (L >= nwg) return false;
        int wgid = (int)L; { const int q = nwg / NXCD, r = nwg % NXCD, xcd = wgid % NXCD, off = wgid / NXCD; wgid = (xcd < r ? xcd * (q + 1) : r * (q + 1) + (xcd - r) * q) + off; }
        const int nig = WGM * nN, gid = wgid / nig, fm = gid * WGM, gsz = (nM - fm) < WGM ? (nM - fm) : WGM;
        u.pm = fm + ((wgid % nig) % gsz); u.pn = (wgid % nig) / gsz; return true;
    }
    __device__ __forceinline__ void a_ready(const Unit&) const {}
    __device__ __forceinline__ void done(const Unit&) const {}
};

__device__ __forceinline__ unsigned cvt_pk_bf16(float lo, float hi) { unsigned r; asm volatile("v_cvt_pk_bf16_f32 %0, %1, %2" : "=v"(r) : "v"(lo), "v"(hi)); return r; }
__device__ __forceinline__ unsigned short cvt_bf16(float x) { return (unsigned short)(cvt_pk_bf16(x, 0.f) & 0xffffu); }
__device__ __forceinline__ float sigmoidf_(float x) { return __builtin_amdgcn_rcpf(1.0f + __expf(-x)); }
__device__ __forceinline__ u32x4 pack8(const f32x4 a, const f32x4 b) { u32x4 w; w.x = cvt_pk_bf16(a[0], a[1]); w.y = cvt_pk_bf16(a[2], a[3]); w.z = cvt_pk_bf16(b[0], b[1]); w.w = cvt_pk_bf16(b[2], b[3]); return w; }

template <int CTRL> __device__ __forceinline__ float dpp1_f(float x) { return __int_as_float(__builtin_amdgcn_update_dpp(0x3f800000, __float_as_int(x), CTRL, 0xf, 0xf, false)); }
template <int CTRL> __device__ __forceinline__ float dpp_f(float x) { return __int_as_float(__builtin_amdgcn_update_dpp(0, __float_as_int(x), CTRL, 0xf, 0xf, true)); }
constexpr float QSCALE = 0.125f * 1.4426950408889634f;

struct EpiInProj {
    static constexpr bool PERM = true, AFTER_DRAIN = false;
    unsigned char* ws;
    __device__ __forceinline__ void operator()(const f32x4 (&acc)[2][2][4][2], const Unit& u, int wr, int wc, int fr, int fq) const {
        const int pn = u.pn; const int row0 = u.pm * BM + wr * 64 + fr;
        if (pn < 4) {
            const float* rope = (const float*)(ws + WS_ROPE);
            bf16_t* dst = (bf16_t*)(ws + ((pn < 2) ? WS_Q : WS_K)); const float sc = (pn < 2) ? QSCALE : 1.0f;
            const int col = 256 * (pn & 1) + 64 * wc + 8 * fq;
#pragma unroll
            for (int ai = 0; ai < 2; ++ai)
#pragma unroll
                for (int m = 0; m < 4; ++m) {
                    const int row = row0 + ai * HALF + m * 16; const int t = row & 8191;
                    const float* cp = rope + (size_t)t * 32 + 8 * fq; const float* sp = cp + 8192 * 32;
                    const f32x4 c0 = *(const f32x4*)cp, c1 = *(const f32x4*)(cp + 4), s0 = *(const f32x4*)sp, s1 = *(const f32x4*)(sp + 4);
                    const f32x4 a0 = acc[ai][0][m][0], a1 = acc[ai][0][m][1], b0 = acc[ai][1][m][0], b1 = acc[ai][1][m][1];
                    const f32x4 o10 = (a0 * c0 - b0 * s0) * sc, o11 = (a1 * c1 - b1 * s1) * sc, o20 = (b0 * c0 + a0 * s0) * sc, o21 = (b1 * c1 + a1 * s1) * sc;
                    bf16_t* rp = dst + (size_t)row * 512 + col;
                    *(u32x4*)rp = pack8(o10, o11); *(u32x4*)(rp + 32) = pack8(o20, o21);
                    asm volatile("" ::: "memory");
                }
        } else if (pn < 6) {
            bf16_t* V = (bf16_t*)(ws + WS_V);
            const int col = 256 * (pn - 4) + 32 * wc + 8 * fq;
#pragma unroll
            for (int ai = 0; ai < 2; ++ai)
#pragma unroll
                for (int m = 0; m < 4; ++m) {
                    const int row = row0 + ai * HALF + m * 16; bf16_t* rp = V + (size_t)row * 512 + col;
                    *(u32x4*)rp = pack8(acc[ai][0][m][0], acc[ai][0][m][1]); *(u32x4*)(rp + HALF) = pack8(acc[ai][1][m][0], acc[ai][1][m][1]);
                }
        } else {
            const int th = pn - 6; const int dbase = 64 * th + 16 * wc + 4 * fq;
            bf16_t* QI = (bf16_t*)(ws + WS_QI); bf16_t* KUT = (bf16_t*)(ws + WS_KUT); float* DEC = (float*)(ws + WS_DEC);
            bf16_t* VT = (bf16_t*)(ws + WS_VT); bf16_t* GS = (bf16_t*)(ws + WS_GS);
            const f32x4 lb4 = *(const f32x4*)((const float*)(ws + WS_LB) + dbase);
            constexpr float L2E = 1.4426950408889634f;
#pragma unroll
            for (int ai = 0; ai < 2; ++ai)
#pragma unroll
                for (int m = 0; m < 4; ++m) {
                    const int row = row0 + ai * HALF + m * 16; const unsigned chunk = (unsigned)row >> 4;
                    const unsigned ro = (unsigned)row * 512u + (unsigned)dbase, co = chunk * 512u + (unsigned)dbase, to = co * 16u + (unsigned)fr;
                    float qi[4], kx[4], dc[4];
#pragma unroll
                    for (int e = 0; e < 4; ++e) {
                        const float lbv = lb4[e], omlb = 1.0f - lbv;
                        const float qv = acc[ai][0][m][0][e], fv = acc[ai][1][m][0][e];
                        const float sg = __builtin_amdgcn_rcpf(1.0f + __builtin_amdgcn_exp2f(-L2E * fv)); const float f = lbv + omlb * sg; const float omf = omlb * (1.0f - sg);
                        float eb = f; eb *= dpp1_f<0x111>(eb); eb *= dpp1_f<0x112>(eb); eb *= dpp1_f<0x114>(eb); eb *= dpp1_f<0x118>(eb);
                        float ebl = f; ebl *= dpp1_f<0x128>(ebl); ebl *= dpp1_f<0x124>(ebl); ebl *= dpp1_f<0x122>(ebl); ebl *= dpp1_f<0x121>(ebl);
                        const float enb = __builtin_amdgcn_rcpf(eb);
                        const float sq = qv * __builtin_amdgcn_rcpf(1.0f + __builtin_amdgcn_exp2f(-L2E * qv));
                        qi[e] = sq * eb; kx[e] = omf * enb; dc[e] = ebl;
                        KUT[to + e * 16u] = cvt_bf16(kx[e] * ebl);
                        VT[to + e * 16u] = cvt_bf16(acc[ai][0][m][1][e]);
                    }
                    u32x2 w; w.x = cvt_pk_bf16(qi[0], qi[1]); w.y = cvt_pk_bf16(qi[2], qi[3]); *(u32x2*)(QI + ro) = w;
                    if (fr == 0) *(f32x4*)(DEC + co) = (f32x4){dc[0], dc[1], dc[2], dc[3]};
                    f32x4 gv = acc[ai][1][m][1];
#pragma unroll
                    for (int e = 0; e < 4; ++e) gv[e] = gv[e] * __builtin_amdgcn_rcpf(1.0f + __builtin_amdgcn_exp2f(-L2E * gv[e]));
                    w.x = cvt_pk_bf16(gv[0], gv[1]); w.y = cvt_pk_bf16(gv[2], gv[3]); *(u32x2*)(GS + ro) = w;
                    asm volatile("" ::: "memory");
                }
        }
    }
};

struct EpiOutProj {
    static constexpr bool PERM = true, AFTER_DRAIN = false;
    const float* X; bf16_t* HR; float* SS;
    __device__ __forceinline__ void operator()(const f32x4 (&acc)[2][2][4][2], const Unit& u, int wr, int wc, int fr, int fq) const {
        const int row0 = u.pm * BM + wr * 64 + fr; const int col0 = u.pn * BM + wc * 32 + 8 * fq;
        f32x4 xn[2][2];
        { const size_t off = (size_t)row0 * 1024 + col0;
#pragma unroll
          for (int bj = 0; bj < 2; ++bj) { xn[bj][0] = *(const f32x4*)(X + off + bj * HALF); xn[bj][1] = *(const f32x4*)(X + off + bj * HALF + 4); } }
#pragma unroll
        for (int i = 0; i < 8; ++i) {
            const int ai = i >> 2, m = i & 3;
            const int row = row0 + ai * HALF + m * 16; const size_t off = (size_t)row * 1024 + col0; float s = 0.f;
            f32x4 xc[2][2];
#pragma unroll
            for (int bj = 0; bj < 2; ++bj) { xc[bj][0] = xn[bj][0]; xc[bj][1] = xn[bj][1]; }
            if (i < 7) { const int rown = row0 + ((i + 1) >> 2) * HALF + ((i + 1) & 3) * 16; const size_t offn = (size_t)rown * 1024 + col0;
#pragma unroll
                for (int bj = 0; bj < 2; ++bj) { xn[bj][0] = *(const f32x4*)(X + offn + bj * HALF); xn[bj][1] = *(const f32x4*)(X + offn + bj * HALF + 4); } }
#pragma unroll
            for (int bj = 0; bj < 2; ++bj) {
                const f32x4 h0 = xc[bj][0] + acc[ai][bj][m][0], h1 = xc[bj][1] + acc[ai][bj][m][1];
                *(u32x4*)(HR + off + bj * HALF) = pack8(h0, h1);
                s += (h0[0] * h0[0] + h0[1] * h0[1]) + (h0[2] * h0[2] + h0[3] * h0[3]) + (h1[0] * h1[0] + h1[1] * h1[1]) + (h1[2] * h1[2] + h1[3] * h1[3]);
            }
            s += __shfl_xor(s, 16); s += __shfl_xor(s, 32);
            if (fq == 0) atomicAdd(SS + row, s);
            asm volatile("" ::: "memory");
        }
    }
};

struct EpiGateUp {
    static constexpr bool PERM = true, AFTER_DRAIN = false;
    bf16_t* ACT; const float* SS;
    __device__ __forceinline__ void operator()(const f32x4 (&acc)[2][2][4][2], const Unit& u, int wr, int wc, int fr, int fq) const {
        const int row0 = u.pm * BM + wr * 64 + fr; const int col0 = u.pn * HALF + wc * 32 + 8 * fq;
#pragma unroll
        for (int ai = 0; ai < 2; ++ai)
#pragma unroll
            for (int m = 0; m < 4; ++m) {
                const int row = row0 + ai * HALF + m * 16; const float rs = __builtin_amdgcn_rsqf(SS[row] * (1.0f / 1024.0f) + 1e-6f);
                f32x4 a0, a1;
#pragma unroll
                for (int e = 0; e < 4; ++e) { const float g0 = acc[ai][0][m][0][e] * rs, u0 = acc[ai][1][m][0][e] * rs, g1 = acc[ai][0][m][1][e] * rs, u1 = acc[ai][1][m][1][e] * rs;
                    a0[e] = g0 * sigmoidf_(g0) * u0; a1[e] = g1 * sigmoidf_(g1) * u1; }
                *(u32x4*)(ACT + (size_t)row * 2816 + col0) = pack8(a0, a1);
            }
    }
};

struct EpiDownNorm {
    static constexpr bool PERM = true, AFTER_DRAIN = true;
    const bf16_t* HR; float* OUT; float* SS; unsigned* cnt; const float* fw;
    __device__ __forceinline__ void fused(f32x4 (&acc)[2][2][4][2], const Unit& u, int wr, int wc, int fr, int fq, PG8_LAS unsigned char* lds, int wid, int lane) const {
        const int row0 = u.pm * BM + wr * 64 + fr; const int col0 = u.pn * BM + wc * 32 + 8 * fq;
        float olds[8] = {0.f, 0.f, 0.f, 0.f, 0.f, 0.f, 0.f, 0.f};
#pragma unroll
        for (int ai = 0; ai < 2; ++ai)
#pragma unroll
            for (int m = 0; m < 4; ++m) {
                const int row = row0 + ai * HALF + m * 16; const unsigned off = (unsigned)row * 1024u + (unsigned)col0; float s = 0.f;
#pragma unroll
                for (int bj = 0; bj < 2; ++bj) {
                    const u32x4 hr = *(const u32x4*)(HR + off + bj * HALF);
                    const f32x4 r0 = (f32x4){__uint_as_float(hr.x << 16), __uint_as_float(hr.x & 0xffff0000u), __uint_as_float(hr.y << 16), __uint_as_float(hr.y & 0xffff0000u)};
                    const f32x4 r1 = (f32x4){__uint_as_float(hr.z << 16), __uint_as_float(hr.z & 0xffff0000u), __uint_as_float(hr.w << 16), __uint_as_float(hr.w & 0xffff0000u)};
                    const f32x4 h0 = r0 + acc[ai][bj][m][0], h1 = r1 + acc[ai][bj][m][1];
                    acc[ai][bj][m][0] = h0; acc[ai][bj][m][1] = h1;
                    s += (h0[0] * h0[0] + h0[1] * h0[1]) + (h0[2] * h0[2] + h0[3] * h0[3]) + (h1[0] * h1[0] + h1[1] * h1[1]) + (h1[2] * h1[2] + h1[3] * h1[3]);
                }
                s += __shfl_xor(s, 16); s += __shfl_xor(s, 32);
                if (fq == 0) olds[ai * 4 + m] = atomicAdd(SS + row, s);
            }
#pragma unroll
        for (int i = 0; i < 8; ++i) asm volatile("" :: "v"(olds[i]));
        asm volatile("s_waitcnt vmcnt(0)" ::: "memory");
        __syncthreads();
        if (wid == 0 && lane == 0) {
            __hip_atomic_fetch_add(cnt + 64 * u.pm, 1u, __ATOMIC_RELAXED, __HIP_MEMORY_SCOPE_AGENT);
            unsigned sp = 0;
            while (__hip_atomic_load(cnt + 64 * u.pm, __ATOMIC_RELAXED, __HIP_MEMORY_SCOPE_AGENT) < 4u) { __builtin_amdgcn_s_sleep(1); if (++sp > (1u << 22)) break; }
        }
        __syncthreads();
        f32x4 w[2][2];
#pragma unroll
        for (int bj = 0; bj < 2; ++bj)
#pragma unroll
            for (int n = 0; n < 2; ++n) w[bj][n] = *(const f32x4*)(fw + col0 + bj * HALF + 4 * n);
        float tots[8];
#pragma unroll
        for (int i = 0; i < 8; ++i) { tots[i] = 0.f; if (fq == 0) tots[i] = atomicAdd(SS + row0 + (i >> 2) * HALF + (i & 3) * 16, 0.0f); }
#pragma unroll
        for (int ai = 0; ai < 2; ++ai)
#pragma unroll
            for (int m = 0; m < 4; ++m) {
                const int row = row0 + ai * HALF + m * 16; const unsigned off = (unsigned)row * 1024u + (unsigned)col0;
                const float tot = __shfl(tots[ai * 4 + m], fr, 64);
                const float rs = __builtin_amdgcn_rsqf(tot * (1.0f / 1024.0f) + 1e-6f);
#pragma unroll
                for (int bj = 0; bj < 2; ++bj) {
                    *(f32x4*)(OUT + off + bj * HALF) = acc[ai][bj][m][0] * rs * w[bj][0]; *(f32x4*)(OUT + off + bj * HALF + 4) = acc[ai][bj][m][1] * rs * w[bj][1];
                }
                asm volatile("" ::: "memory");
            }
    }
};

template <class Epi, class Sched, bool ALIGN_EPI = false, bool SP2 = false>
__device__ __forceinline__ void gemm_phase(PG8_LAS unsigned char* lds, const Gemm g, const Sched& S, const Epi& E) {
    int tid_ = threadIdx.x; asm volatile("" : "+v"(tid_));
    const int tid = tid_, wid = __builtin_amdgcn_readfirstlane(tid >> 6), lane = tid & 63, wr = wid >> 2, wc = wid & 3, fr = lane & 15, fq = lane >> 4;
    const int K = g.K, nt = K / BK;
    unsigned voffA[2], voffB[2];
#pragma unroll
    for (int i = 0; i < 2; ++i) { int R, C; stage_rc(tid * 16 + i * 8192, R, C); const int Rb = Epi::PERM ? ((R & ~31) + perm32(R & 31)) : R;
        voffA[i] = (unsigned)(R * K + C) * 2u; voffB[i] = (unsigned)(Rb * K + C) * 2u; }
    const size_t kstep = (size_t)(BK * 2);
    const size_t hstep = (size_t)HALF * K * 2;
    const size_t tstep = 2 * hstep;
    const unsigned ldsw = (unsigned)wid * 1024u;
    const int aoff = lds_byte(wr * 64 + fr, fq * 8), boff = lds_byte(wc * 32 + fr, fq * 8);
#define PG8_SA(b, h) (((b) * 2 + (h)) * HTB)
#define PG8_SB(b, h) ((4 + (b) * 2 + (h)) * HTB)
#define PG8_STAGE(bufoff, gbase, voff) do { _Pragma("unroll") for (int _i = 0; _i < 2; ++_i) \
        __builtin_amdgcn_global_load_lds((const unsigned*)((const char*)(gbase) + (voff)[_i]), (PG8_LAS unsigned*)(lds + (bufoff) + ldsw + _i * 8192), 16, 0, 0); } while (0)
#define PG8_LDA(dst, b, h) do { _Pragma("unroll") for (int m = 0; m < 4; ++m) _Pragma("unroll") for (int k = 0; k < 2; ++k) dst[m][k] = *(const PG8_LAS bf16x8*)(lds + PG8_SA(b, h) + aoff + m * 2048 + k * 1024); } while (0)
#define PG8_LDB(dst, b, h) do { _Pragma("unroll") for (int n = 0; n < 2; ++n) _Pragma("unroll") for (int k = 0; k < 2; ++k) dst[n][k] = *(const PG8_LAS bf16x8*)(lds + PG8_SB(b, h) + boff + n * 2048 + k * 1024); } while (0)
#define PG8_MMA(ai, bj, At, Bt) do { __builtin_amdgcn_s_setprio(1); _Pragma("unroll") for (int m = 0; m < 4; ++m) _Pragma("unroll") for (int n = 0; n < 2; ++n) _Pragma("unroll") for (int k = 0; k < 2; ++k) \
        acc[ai][bj][m][n] = __builtin_amdgcn_mfma_f32_16x16x32_bf16(Bt[n][k], At[m][k], acc[ai][bj][m][n], 0, 0, 0); __builtin_amdgcn_s_setprio(0); } while (0)
#define PG8_WAIT_V(n) asm volatile("s_waitcnt vmcnt(" #n ")" ::: "memory")
#define PG8_WAIT_L(n) asm volatile("s_waitcnt lgkmcnt(" #n ")" ::: "memory")
#define PG8_BAR __builtin_amdgcn_s_barrier()
#define PG8_SCHED __builtin_amdgcn_sched_barrier(0)
    Unit cur, nxt; int ui = 0;
    if (!S.next(0, cur)) return;
    f32x4 acc[2][2][4][2];
#pragma unroll
    for (int a = 0; a < 2; ++a)
#pragma unroll
        for (int b = 0; b < 2; ++b)
#pragma unroll
            for (int m = 0; m < 4; ++m)
#pragma unroll
                for (int n = 0; n < 2; ++n) acc[a][b][m][n] = (f32x4){0.f, 0.f, 0.f, 0.f};
    bf16x8 At[4][2], B0[2][2], B1[2][2];
    const char* cA = (const char*)g.A + (size_t)cur.pm * tstep; const char* cB = (const char*)g.Bt + (size_t)cur.pn * tstep;
    S.a_ready(cur);
    if constexpr (SP2) {
        PG8_STAGE(PG8_SB(0, 0), cB, voffB); PG8_STAGE(PG8_SB(0, 1), cB + hstep, voffB); PG8_STAGE(PG8_SA(0, 0), cA, voffA); PG8_STAGE(PG8_SA(0, 1), cA + hstep, voffA);
        if (wr == 1) PG8_BAR;
        PG8_WAIT_V(2); PG8_BAR;
        PG8_STAGE(PG8_SB(1, 0), cB + kstep, voffB); PG8_STAGE(PG8_SA(1, 0), cA + kstep, voffA); PG8_STAGE(PG8_SB(1, 1), cB + hstep + kstep, voffB);
        PG8_WAIT_V(6); PG8_BAR;
    } else {
        PG8_STAGE(PG8_SB(0, 0), cB, voffB); PG8_STAGE(PG8_SA(0, 0), cA, voffA); PG8_STAGE(PG8_SB(0, 1), cB + hstep, voffB); PG8_STAGE(PG8_SA(0, 1), cA + hstep, voffA);
        if (wr == 1) PG8_BAR;
        PG8_WAIT_V(4); PG8_BAR;
        PG8_STAGE(PG8_SB(1, 0), cB + kstep, voffB); PG8_STAGE(PG8_SA(1, 0), cA + kstep, voffA); PG8_STAGE(PG8_SB(1, 1), cB + hstep + kstep, voffB);
        PG8_WAIT_V(6); PG8_BAR;
    }
    for (;;) {
        const bool has_next = S.next(ui + 1, nxt);
        const char* nA = has_next ? (const char*)g.A + (size_t)nxt.pm * tstep : cA; const char* nB = has_next ? (const char*)g.Bt + (size_t)nxt.pn * tstep : cB;
        for (int t = 0; t < nt; t += 2) {
            const bool last = (t == nt - 2);
            const char* a1 = cA + (size_t)(t + 1) * kstep;
            const char* a2 = last ? nA : cA + (size_t)(t + 2) * kstep; const char* b2 = last ? nB : cB + (size_t)(t + 2) * kstep;
            const char* a3 = a2 + kstep; const char* b3 = b2 + kstep;
            if (last && has_next) S.a_ready(nxt);
            if constexpr (SP2) {
            PG8_LDB(B0, 0, 0); PG8_LDB(B1, 0, 1); PG8_SCHED; PG8_LDA(At, 0, 0); PG8_STAGE(PG8_SA(1, 1), a1 + hstep, voffA);
            PG8_WAIT_V(8); PG8_WAIT_L(0); PG8_BAR; PG8_MMA(0, 0, At, B0); PG8_MMA(0, 1, At, B1); PG8_BAR; PG8_SCHED;
            PG8_LDA(At, 0, 1); PG8_STAGE(PG8_SB(0, 0), b2, voffB); PG8_STAGE(PG8_SB(0, 1), b2 + hstep, voffB); PG8_STAGE(PG8_SA(0, 0), a2, voffA);
            PG8_WAIT_V(8); PG8_WAIT_L(0); PG8_BAR; PG8_MMA(1, 0, At, B0); PG8_MMA(1, 1, At, B1); PG8_BAR; PG8_SCHED;
            PG8_LDB(B0, 1, 0); PG8_LDB(B1, 1, 1); PG8_SCHED; PG8_LDA(At, 1, 0); PG8_STAGE(PG8_SA(0, 1), a2 + hstep, voffA);
            PG8_WAIT_V(8); PG8_WAIT_L(0); PG8_BAR; PG8_MMA(0, 0, At, B0); PG8_MMA(0, 1, At, B1); PG8_BAR; PG8_SCHED;
            PG8_LDA(At, 1, 1); PG8_STAGE(PG8_SB(1, 0), b3, voffB); PG8_STAGE(PG8_SB(1, 1), b3 + hstep, voffB); PG8_STAGE(PG8_SA(1, 0), a3, voffA);
            PG8_WAIT_V(8); PG8_WAIT_L(0); PG8_BAR; PG8_MMA(1, 0, At, B0); PG8_MMA(1, 1, At, B1); PG8_BAR; PG8_SCHED;
            } else {
            PG8_LDB(B0, 0, 0); PG8_SCHED; PG8_LDA(At, 0, 0); PG8_STAGE(PG8_SA(1, 1), a1 + hstep, voffA);
            PG8_WAIT_L(8); PG8_BAR; PG8_WAIT_L(0); PG8_MMA(0, 0, At, B0); PG8_BAR; PG8_SCHED;
            PG8_LDB(B1, 0, 1); PG8_STAGE(PG8_SB(0, 0), b2, voffB);
            PG8_BAR; PG8_WAIT_L(0); PG8_MMA(0, 1, At, B1); PG8_BAR;
            PG8_LDA(At, 0, 1); PG8_STAGE(PG8_SA(0, 0), a2, voffA);
            PG8_BAR; PG8_WAIT_L(0); PG8_MMA(1, 0, At, B0); PG8_BAR; PG8_SCHED;
            PG8_STAGE(PG8_SB(0, 1), b2 + hstep, voffB);
            PG8_WAIT_V(6); PG8_BAR; PG8_MMA(1, 1, At, B1); PG8_BAR;
            PG8_LDB(B0, 1, 0); PG8_SCHED; PG8_LDA(At, 1, 0); PG8_STAGE(PG8_SA(0, 1), a2 + hstep, voffA);
            PG8_WAIT_L(8); PG8_BAR; PG8_WAIT_L(0); PG8_MMA(0, 0, At, B0); PG8_BAR; PG8_SCHED;
            PG8_LDB(B1, 1, 1); PG8_STAGE(PG8_SB(1, 0), b3, voffB);
            PG8_BAR; PG8_WAIT_L(0); PG8_MMA(0, 1, At, B1); PG8_BAR;
            PG8_LDA(At, 1, 1); PG8_STAGE(PG8_SA(1, 0), a3, voffA);
            PG8_BAR; PG8_WAIT_L(0); PG8_MMA(1, 0, At, B0); PG8_BAR; PG8_SCHED;
            PG8_STAGE(PG8_SB(1, 1), b3 + hstep, voffB);
            PG8_WAIT_V(6); PG8_BAR; PG8_MMA(1, 1, At, B1); PG8_BAR;
            }
        }
        if constexpr (ALIGN_EPI) { if (wr == 0) PG8_BAR; }
        if constexpr (!Epi::AFTER_DRAIN) { E(acc, cur, wr, wc, fr, fq); S.done(cur); }
        if (!has_next) break;
#pragma unroll
        for (int a = 0; a < 2; ++a)
#pragma unroll
            for (int b = 0; b < 2; ++b)
#pragma unroll
                for (int m = 0; m < 4; ++m)
#pragma unroll
                    for (int n = 0; n < 2; ++n) acc[a][b][m][n] = (f32x4){0.f, 0.f, 0.f, 0.f};
        cur = nxt; cA = nA; cB = nB; ++ui;
        if constexpr (ALIGN_EPI) { if (wr == 1) PG8_BAR; }
    }
    PG8_WAIT_V(0);
    if constexpr (!ALIGN_EPI) { if (wr == 0) PG8_BAR; }
    PG8_BAR;
    if constexpr (Epi::AFTER_DRAIN) { E.fused(acc, cur, wr, wc, fr, fq, lds, wid, lane); S.done(cur); }
#undef PG8_SA
#undef PG8_SB
#undef PG8_STAGE
#undef PG8_LDA
#undef PG8_LDB
#undef PG8_MMA
#undef PG8_WAIT_V
#undef PG8_WAIT_L
#undef PG8_BAR
#undef PG8_SCHED
}
}

constexpr int RING_BYTES = 131072, LDS_BYTES = 147456;

#define GAS __attribute__((address_space(1)))
#define LAS __attribute__((address_space(3)))
typedef unsigned short bf16;
typedef float f32x4 __attribute__((ext_vector_type(4)));
typedef float f32x16 __attribute__((ext_vector_type(16)));
typedef short bf16x8 __attribute__((ext_vector_type(8)));
typedef short s16x4 __attribute__((ext_vector_type(4)));
typedef unsigned u32x4 __attribute__((ext_vector_type(4)));
typedef unsigned u32x2 __attribute__((ext_vector_type(2)));
using pg8::cvt_pk_bf16; using pg8::cvt_bf16;

__device__ __forceinline__ float bf2f(unsigned short h) { return __uint_as_float(((unsigned)h) << 16); }

__device__ __forceinline__ int bt_row_inproj(int c) {
    if (c < 1024) { const int region = c >> 9, cc = c & 511; const int tr = cc >> 8, hl = (cc >> 6) & 3, half = (cc >> 5) & 1, idx = cc & 31; return 256 * (2 * region + tr) + 128 * half + 32 * hl + idx; }
    if (c < 1536) return c;
    const int cc = c - 1536; const int arr = cc >> 9, d = cc & 511; const int th = d >> 6, dd = d & 63;
    return 256 * (6 + th) + 128 * (arr & 1) + 32 * (dd >> 4) + 8 * ((dd >> 2) & 3) + 4 * (arr >> 1) + (dd & 3);
}
__device__ __forceinline__ int bt_row_gu(int c) { if (c < FFH) return 256 * (c >> 7) + (c & 127); const int j = c - FFH; return 256 * (j >> 7) + 128 + (j & 127); }

template <int MAP> __device__ __forceinline__ void p0_transpose_item(const float* W, int K, int N, bf16* WT, LAS float* scr, int item, int lane, const float* kscale = nullptr) {
    const int nblk = N / 32, kb = item / nblk, nb = item % nblk, k0 = 64 * kb, n0 = 32 * nb;
#pragma unroll 8
    for (int i = 0; i < 32; ++i) { const int kk = 2 * i + (lane >> 5); scr[kk * 33 + (lane & 31)] = W[(size_t)(k0 + kk) * N + n0 + (lane & 31)]; }
    asm volatile("s_waitcnt lgkmcnt(0)" ::: "memory");
    const int c = lane & 7;
    f32x4 ks0 = (f32x4){1.f, 1.f, 1.f, 1.f}, ks1 = ks0;
    if (kscale) { ks0 = *(const f32x4*)(kscale + k0 + 8 * c); ks1 = *(const f32x4*)(kscale + k0 + 8 * c + 4); }
#pragma unroll
    for (int j = 0; j < 4; ++j) { const int n = (lane >> 3) + 8 * j; const LAS float* s = scr + (8 * c) * 33 + n;
        u32x4 o; o.x = cvt_pk_bf16(s[0 * 33] * ks0[0], s[1 * 33] * ks0[1]); o.y = cvt_pk_bf16(s[2 * 33] * ks0[2], s[3 * 33] * ks0[3]); o.z = cvt_pk_bf16(s[4 * 33] * ks1[0], s[5 * 33] * ks1[1]); o.w = cvt_pk_bf16(s[6 * 33] * ks1[2], s[7 * 33] * ks1[3]);
        const int rr = (MAP == 1) ? bt_row_inproj(n0 + n) : (MAP == 2) ? bt_row_gu(n0 + n) : n0 + n;
        *(u32x4*)(WT + (size_t)rr * K + k0 + 8 * c) = o; }
    asm volatile("s_waitcnt lgkmcnt(0)" ::: "memory");
}
__device__ __forceinline__ float wave_sum(float v) {
#pragma unroll
    for (int o = 1; o < 64; o <<= 1) v += __shfl_xor(v, o);
    return v;
}

#define RLX_AGENT __ATOMIC_RELAXED, __HIP_MEMORY_SCOPE_AGENT
#define XB_TMO      128
#define XB_XCNT(j)  (256  + 64 * (j))
#define XB_XSUB(j)  (1280 + 64 * (j))
#define XB_XGEN(j)  (2304 + 64 * (j))
#define XB_TOP      3328
#define XB_TOPGEN   3392
#define XCD_BAR_WORDS 3456
#define XB_SPIN_CAP (1u << 18)

__device__ __forceinline__ unsigned xb_ld(unsigned* p)              { return __hip_atomic_load(p, __ATOMIC_RELAXED, __HIP_MEMORY_SCOPE_AGENT); }
__device__ __forceinline__ unsigned xb_add(unsigned* p, unsigned v) { return __hip_atomic_fetch_add(p, v, __ATOMIC_RELAXED, __HIP_MEMORY_SCOPE_AGENT); }
__device__ __forceinline__ unsigned xb_xcc_id() { return (unsigned)__builtin_amdgcn_s_getreg((3 << 11) | 20) & 0xFu; }
#define XB_SPIN(cond, bar) do { unsigned _sp = 0; while (cond) { __builtin_amdgcn_s_sleep(1); \
    if ((++_sp & 255u) == 0u) { if (xb_ld(&(bar)[XB_TMO])) break; if (_sp > XB_SPIN_CAP) { atomicAdd(&(bar)[XB_TMO], 1u); break; } } } } while (0)

struct XcdBarrier {
    unsigned* bar; unsigned x;
    volatile LAS unsigned* st;
};

__device__ __forceinline__ XcdBarrier xcd_barrier_post(unsigned* bar, volatile LAS unsigned* st) {
    XcdBarrier b; b.bar = bar; b.x = xb_xcc_id(); b.st = st;
    if (threadIdx.x == 0) (void)xb_add(&bar[XB_XCNT(b.x)], 1u);
    return b;
}
__device__ __forceinline__ void xcd_barrier_complete(unsigned* bar, unsigned x, unsigned& nloc, unsigned& nx) {
    const unsigned G = gridDim.x * gridDim.y * gridDim.z;
    unsigned sum, cnt, mine, sp = 0u;
    for (;;) {
        sum = 0u; cnt = 0u; mine = 0u;
#pragma unroll
        for (unsigned j = 0; j < 16; ++j) { const unsigned c = xb_ld(&bar[XB_XCNT(j)]); sum += c; cnt += (c > 0u) ? 1u : 0u; mine = (j == x) ? c : mine; }
        if (sum == G) break;
        __builtin_amdgcn_s_sleep(1);
        if ((++sp & 255u) == 0u) { if (xb_ld(&bar[XB_TMO])) break; if (sp > XB_SPIN_CAP) { atomicAdd(&bar[XB_TMO], 1u); break; } }
    }
    nloc = mine > 0u ? mine : 1u; nx = cnt > 0u ? cnt : 1u;
}

__device__ __forceinline__ void xcd_barrier(const XcdBarrier& b) {
    asm volatile("s_waitcnt vmcnt(0)" ::: "memory");
    __syncthreads();
    if (threadIdx.x == 0) {
        unsigned* bar = b.bar;
        __builtin_amdgcn_s_waitcnt(0);
        unsigned nloc = b.st[0], nx = b.st[1];
        if (nloc == 0u) { xcd_barrier_complete(bar, b.x, nloc, nx); b.st[0] = nloc; b.st[1] = nx; }
        const unsigned old = xb_add(&bar[XB_XSUB(b.x)], 1u);
        const unsigned gen = old / nloc;
        if (old + 1u == (gen + 1u) * nloc) {
            __builtin_amdgcn_fence(__ATOMIC_RELEASE, "agent");
            asm volatile("s_waitcnt vmcnt(0)" ::: "memory");
            const unsigned og = xb_add(&bar[XB_TOP], 1u);
            const unsigned tg = og / nx;
            if (og + 1u == (tg + 1u) * nx) xb_add(&bar[XB_TOPGEN], 1u);
            else XB_SPIN(xb_ld(&bar[XB_TOPGEN]) == tg, bar);
            __builtin_amdgcn_fence(__ATOMIC_ACQUIRE, "agent");
            xb_add(&bar[XB_XGEN(b.x)], 1u);
            asm volatile("s_waitcnt vmcnt(0)" ::: "memory");
        } else {
            XB_SPIN(xb_ld(&bar[XB_XGEN(b.x)]) == gen, bar);
            __builtin_amdgcn_fence(__ATOMIC_ACQUIRE, "agent");
            asm volatile("s_waitcnt vmcnt(0)" ::: "memory");
        }
    }
    __syncthreads();
}

struct Args { const float* in[10]; float* out; unsigned char* ws; };
__device__ __forceinline__ void prefetch_lines(const unsigned char* p, int nlines, int gt, int NGT) {
    for (int i = gt; i < nlines; i += NGT) { const unsigned v = *(const unsigned*)(p + (size_t)i * 128); asm volatile("" :: "v"(v)); }
}

__device__ __forceinline__ void p0_prologue(const Args& a, LAS unsigned char* lds, int gw, int NGW, int wave, int lane) {
    unsigned char* ws = a.ws;
    LAS float* scr = (LAS float*)(lds + wave * 16384);
    constexpr int I_IN = (DM / 64) * (NIN / 32);
    for (int it = gw; it < I_IN; it += NGW) p0_transpose_item<1>(a.in[2], DM, NIN, (bf16*)(ws + WS_WIN), scr, it, lane);
    const float* x = a.in[0]; const float* n1 = a.in[1]; bf16* XN = (bf16*)(ws + WS_XN);
    f32x4 nwv[4];
#pragma unroll
    for (int j = 0; j < 4; ++j) nwv[j] = *((const f32x4*)n1 + lane + 64 * j);
    for (int mi = gw; mi < M; mi += NGW) {
        const int m = (NGW == 2048) ? (2048 * ((mi >> 3) & 7) + 64 * ((mi >> 6) & 31) + 8 * (mi & 7) + (mi >> 11)) : mi;
        const f32x4* xr = (const f32x4*)(x + (size_t)m * DM) + lane; f32x4 v[4]; float s = 0.f;
#pragma unroll
        for (int j = 0; j < 4; ++j) { v[j] = __builtin_nontemporal_load(xr + 64 * j); s += (v[j].x * v[j].x + v[j].y * v[j].y) + (v[j].z * v[j].z + v[j].w * v[j].w); }
        const float rs = 1.0f / sqrtf(wave_sum(s) * (1.0f / DM) + EPS);
        u32x2* o8 = (u32x2*)(XN + (size_t)m * DM) + lane;
#pragma unroll
        for (int j = 0; j < 4; ++j) { const f32x4 y = v[j] * rs * nwv[j]; u32x2 w; w.x = cvt_pk_bf16(y.x, y.y); w.y = cvt_pk_bf16(y.z, y.w); o8[64 * j] = w; }
    }
    if (gw == 0) { const float* ll = a.in[3]; float* lbt = (float*)(ws + WS_LB); for (int i = lane; i < 512; i += 64) lbt[i] = 1.0f / (1.0f + expf(ll[512 + i] - ll[i])); }
    const int gt = gw * 64 + lane, NGT = NGW * 64;
    float* rope = (float*)(ws + WS_ROPE);
    for (int i = gt; i < SEQ * 32; i += NGT) { const int t = i >> 5, k = i & 31; const float inv = powf(10000.0f, -(float)k / 32.0f); const float ang = (float)t * inv;
        rope[i] = cosf(ang); rope[SEQ * 32 + i] = sinf(ang); }
}

__device__ __forceinline__ void convert_rest(const Args& a, LAS unsigned char* lds, int gw2, int NGW2, int wave, int lane) {
    unsigned char* ws = a.ws;
    LAS float* scr = (LAS float*)(lds + wave * 16384);
    constexpr int I_OUT = (DM / 64) * (DM / 32), I_GU = (DM / 64) * (NGU / 32), I_DN = (FFH / 64) * (DM / 32);
    for (int it = gw2; it < I_OUT + I_GU + I_DN; it += NGW2) {
        int r = it;
        if (r < I_OUT) { p0_transpose_item<0>(a.in[5], DM, DM, (bf16*)(ws + WS_WOUT), scr, r, lane); continue; } r -= I_OUT;
        if (r < I_GU) { p0_transpose_item<2>(a.in[7], DM, NGU, (bf16*)(ws + WS_WGU), scr, r, lane, a.in[6]); continue; } r -= I_GU;
        p0_transpose_item<0>(a.in[8], FFH, DM, (bf16*)(ws + WS_WDN), scr, r, lane);
    }
}

constexpr int KPITCH = 144, KROWS = 384, VOFF = KROWS * KPITCH;
__device__ __forceinline__ int crow(int r, int hi) { return (r & 3) + 8 * (r >> 2) + 4 * hi; }
__device__ __forceinline__ s16x4 vtr(const LAS unsigned char* p) { typedef short v4i16_t __attribute__((ext_vector_type(4))); return __builtin_bit_cast(s16x4, __builtin_amdgcn_ds_read_tr16_b64_v4i16((LAS v4i16_t*)p)); }

struct AttnU { int pat, b, h, r, m0, dsh; };
__device__ __forceinline__ AttnU attn_decode(int unit) {
    AttnU U; U.pat = unit >> 9; const int rem = unit & 511, bh = rem >> 5, blk = rem & 31; U.b = bh >> 3; U.h = bh & 7;
    U.dsh = 2 * U.pat;
    const int bps = 32 >> U.dsh;
    U.r = blk / bps; U.m0 = 256 * (blk % bps); return U;
}
__device__ __forceinline__ void attn_load(const AttnU& U, unsigned char* ws, int tid, int wave, int lane, u32x4 (&kr)[6], u32x4 (&vr)[6], bf16x8 (&qf)[4]) {
    const bf16* Qg = (const bf16*)(ws + WS_Q) + (size_t)U.b * SEQ * 512 + U.h * 64;
    const bf16* Kg = (const bf16*)(ws + WS_K) + (size_t)U.b * SEQ * 512 + U.h * 64;
    const bf16* Vg = (const bf16*)(ws + WS_V) + (size_t)U.b * SEQ * 512 + U.h * 64;
#pragma unroll
    for (int it = 0; it < 6; ++it) {
        const int i = tid + it * NTHR; const int row = i >> 3, ch = i & 7; const int mk = U.m0 - 128 + row;
        kr[it] = (u32x4){0u, 0u, 0u, 0u}; vr[it] = (u32x4){0u, 0u, 0u, 0u};
        if (mk >= 0) { const unsigned off = (unsigned)((mk << U.dsh) + U.r) * 512u + (unsigned)(ch * 8); kr[it] = *(const u32x4*)(Kg + off); vr[it] = *(const u32x4*)(Vg + off); }
    }
    const int ql = lane & 31, hi = lane >> 5; const int mq = U.m0 + 32 * wave + ql; const unsigned tq = (unsigned)((mq << U.dsh) + U.r);
#pragma unroll
    for (int kk = 0; kk < 4; ++kk) qf[kk] = *(const bf16x8*)(Qg + tq * 512u + (unsigned)(16 * kk + 8 * hi));
}
__device__ __forceinline__ void attn_stage(LAS unsigned char* lds, int tid, const u32x4 (&kr)[6], const u32x4 (&vr)[6]) {
#pragma unroll
    for (int it = 0; it < 6; ++it) { const int i = tid + it * NTHR; const int row = i >> 3, ch = i & 7;
        *(LAS u32x4*)(lds + row * KPITCH + ch * 16) = kr[it]; *(LAS u32x4*)(lds + VOFF + row * KPITCH + ch * 16) = vr[it]; }
}
__device__ __forceinline__ void attn_compute(const AttnU& U, LAS unsigned char* lds, unsigned char* ws, int wave, int lane, const bf16x8 (&qf)[4]) {
    const int pat = U.pat, m0 = U.m0, dsh = U.dsh, r = U.r;
    bf16* Og = (bf16*)(ws + (pat == 0 ? WS_OP0 : pat == 1 ? WS_OP1 : WS_OP2)) + (size_t)U.b * SEQ * 512 + U.h * 64;
    float* Lg = (float*)(ws + WS_LSE) + ((size_t)(pat * 16 + U.b * 8 + U.h) * SEQ + (size_t)r * (SEQ >> dsh));
    const int ql = lane & 31, hi = lane >> 5;
    const int mq = m0 + 32 * wave + ql; const size_t tq = (size_t)((mq << dsh) + r);
    f32x16 st[5];
#pragma unroll
    for (int kt = 0; kt < 5; ++kt) {
        st[kt] = (f32x16){};
        const LAS unsigned char* kp = lds + (32 * wave + 32 * kt + ql) * KPITCH + 16 * hi;
#pragma unroll
        for (int kk = 0; kk < 4; ++kk) { const bf16x8 kf = *(const LAS bf16x8*)(kp + 32 * kk); st[kt] = __builtin_amdgcn_mfma_f32_32x32x16_bf16(kf, qf[kk], st[kt], 0, 0, 0); }
    }
    const float NEG = -1e30f; float mx = NEG;
#pragma unroll
    for (int kt = 0; kt < 5; ++kt)
#pragma unroll
        for (int i = 0; i < 16; ++i) {
            const int cr = crow(i, hi); const int R = 32 * wave + 32 * kt + cr;
            bool ok = (m0 - 128 + R) >= 0;
            if (kt == 0) ok = ok && (cr >= ql);
            if (kt == 4) ok = ok && (cr <= ql);
            const float s = ok ? st[kt][i] : NEG; st[kt][i] = s; mx = fmaxf(mx, s);
        }
    mx = fmaxf(mx, __shfl_xor(mx, 32));
    float lsum = 0.f;
#pragma unroll
    for (int kt = 0; kt < 5; ++kt)
#pragma unroll
        for (int i = 0; i < 16; ++i) { const float p = __builtin_amdgcn_exp2f(st[kt][i] - mx); st[kt][i] = p; lsum += p; }
    lsum += __shfl_xor(lsum, 32);
    f32x16 o[2]; o[0] = (f32x16){}; o[1] = (f32x16){};
    const int blk16 = (lane >> 4) & 1, q4 = (lane & 15) >> 2, p4 = lane & 3;
    const LAS unsigned char* vbase = lds + VOFF + (32 * wave + 4 * hi + q4) * KPITCH + (16 * blk16 + 4 * p4) * 2;
#pragma unroll
    for (int kt = 0; kt < 5; ++kt)
#pragma unroll
        for (int ks = 0; ks < 2; ++ks) {
            u32x4 pw; pw.x = cvt_pk_bf16(st[kt][8 * ks + 0], st[kt][8 * ks + 1]); pw.y = cvt_pk_bf16(st[kt][8 * ks + 2], st[kt][8 * ks + 3]);
            pw.z = cvt_pk_bf16(st[kt][8 * ks + 4], st[kt][8 * ks + 5]); pw.w = cvt_pk_bf16(st[kt][8 * ks + 6], st[kt][8 * ks + 7]);
            const bf16x8 pb = __builtin_bit_cast(bf16x8, pw);
#pragma unroll
            for (int c = 0; c < 2; ++c) {
                const LAS unsigned char* vp = vbase + (32 * kt + 16 * ks) * KPITCH + 64 * c;
                const s16x4 v0 = vtr(vp), v1 = vtr(vp + 8 * KPITCH);
                const bf16x8 va = (bf16x8){v0[0], v0[1], v0[2], v0[3], v1[0], v1[1], v1[2], v1[3]};
                o[c] = __builtin_amdgcn_mfma_f32_32x32x16_bf16(va, pb, o[c], 0, 0, 0);
            }
        }
    const float rl = 1.0f / lsum;
    bf16* orow = Og + tq * 512;
#pragma unroll
    for (int c = 0; c < 2; ++c)
#pragma unroll
        for (int g = 0; g < 4; ++g) { u32x2 w; w.x = cvt_pk_bf16(o[c][4 * g] * rl, o[c][4 * g + 1] * rl); w.y = cvt_pk_bf16(o[c][4 * g + 2] * rl, o[c][4 * g + 3] * rl);
            *(u32x2*)(orow + 32 * c + 8 * g + 4 * hi) = w; }
    if (hi == 0) Lg[mq] = mx + __builtin_amdgcn_logf(lsum);
}
__device__ __forceinline__ void attn_phase(LAS unsigned char* lds, unsigned char* ws, int bx, int G, int tid, int wave, int lane) {
    u32x4 kr[6], vr[6]; bf16x8 qn[4], qc[4];
    int u = (G % 8 == 0) ? (bx & 7) * (G >> 3) + (bx >> 3) : bx;
    if (u >= 1536) return;
    AttnU U = attn_decode(u); attn_load(U, ws, tid, wave, lane, kr, vr, qn);
    for (; u < 1536; u += G) {
        attn_stage(lds, tid, kr, vr);
#pragma unroll
        for (int kk = 0; kk < 4; ++kk) qc[kk] = qn[kk];
        __syncthreads();
        const AttnU Uc = U; const int un = u + G;
        if (un < 1536) { U = attn_decode(un); attn_load(U, ws, tid, wave, lane, kr, vr, qn); }
        attn_compute(Uc, lds, ws, wave, lane, qc);
        __syncthreads();
    }
}

__device__ __forceinline__ int psi(int j, int c) { return 32 * (j >> 1) + 8 * (c >> 2) + 4 * (j & 1) + (c & 3); }
__device__ __forceinline__ int kut_lds_off(int p) { const int dk = p >> 1; const int j = 2 * (dk >> 5) + ((dk >> 2) & 1), c = 4 * ((dk >> 3) & 3) + (dk & 3), g0 = 2 * (p & 1); return ((j * 4 + g0) * 16 + c) * 8; }

constexpr int P1_VT_OFF = 65536, P1_DEC_OFF = 131072;
__device__ __forceinline__ void hgrn_pass1(int item, LAS unsigned char* lds, unsigned char* ws, int tid, int wave, int lane) {
    const int seq = item >> 5, sc = item & 31, b = seq >> 2, h = seq & 3; const int g = lane >> 4, c = lane & 15;
    const int chunk0 = (b * SEQ + sc * 256) >> 4;
    const bf16* KUT = (const bf16*)(ws + WS_KUT); const bf16* VT = (const bf16*)(ws + WS_VT); const float* DEC = (const float*)(ws + WS_DEC);
    u32x4 st[8], sv[8];
#pragma unroll
    for (int it = 0; it < 8; ++it) { const int idx = tid + NTHR * it; const int ck = idx >> 8, p = idx & 255; const size_t go = ((size_t)(chunk0 + ck) * 512 + h * 128) * 16 + p * 8;
        st[it] = *(const u32x4*)(KUT + go); sv[it] = *(const u32x4*)(VT + go); }
    const f32x4 sd = *(const f32x4*)(DEC + (size_t)(chunk0 + (tid >> 5)) * 512 + h * 128 + 4 * (tid & 31));
#pragma unroll
    for (int it = 0; it < 8; ++it) { const int idx = tid + NTHR * it; const int ck = idx >> 8, p = idx & 255; LAS unsigned char* d = lds + ck * 4096 + kut_lds_off(p);
        *(LAS u32x2*)d = (u32x2){st[it].x, st[it].y}; *(LAS u32x2*)(d + 128) = (u32x2){st[it].z, st[it].w};
        *(LAS u32x4*)(lds + P1_VT_OFF + idx * 16) = sv[it]; }
    *(LAS f32x4*)(lds + P1_DEC_OFF + tid * 16) = sd;
    __syncthreads();
    f32x4 S[8], dt[8];
#pragma unroll
    for (int j = 0; j < 8; ++j) { S[j] = (f32x4){0.f, 0.f, 0.f, 0.f}; dt[j] = (f32x4){1.f, 1.f, 1.f, 1.f}; }
#pragma unroll 2
    for (int ck = 0; ck < 16; ++ck) {
        const s16x4 vb = *(const LAS s16x4*)(lds + P1_VT_OFF + ck * 4096 + ((16 * wave + c) * 16 + 4 * g) * 2);
#pragma unroll
        for (int j = 0; j < 8; ++j) {
            const s16x4 ka = *(const LAS s16x4*)(lds + ck * 4096 + ((j * 4 + g) * 16 + c) * 8);
            const f32x4 dc = *(const LAS f32x4*)(lds + P1_DEC_OFF + (ck * 128 + 32 * (j >> 1) + 8 * g + 4 * (j & 1)) * 4);
            S[j] = __builtin_amdgcn_mfma_f32_16x16x16bf16_1k(ka, vb, S[j] * dc, 0, 0, 0); dt[j] = dt[j] * dc;
        }
    }
    bf16* U = (bf16*)(ws + WS_U) + (size_t)item * 16384;
#pragma unroll
    for (int j = 0; j < 8; ++j) { u32x2 w; w.x = cvt_pk_bf16(S[j][0], S[j][1]); w.y = cvt_pk_bf16(S[j][2], S[j][3]); *(u32x2*)(U + ((wave * 8 + j) * 64 + lane) * 4) = w; }
    if (wave == 0 && c == 0) { float* D = (float*)(ws + WS_DTOT) + item * 128;
#pragma unroll
        for (int j = 0; j < 8; ++j) *(f32x4*)(D + 32 * (j >> 1) + 8 * g + 4 * (j & 1)) = dt[j]; }
    __syncthreads();
}

constexpr int OPITCH = 132, P3_QI = 16384, P3_KX = 32768, P3_VT = 49152, P3_DEC = 65536, P3_OT = 67584;
__device__ __forceinline__ void hgrn_pass3(int item, LAS unsigned char* lds, unsigned char* ws, const float* nw, int tid, int wave, int lane) {
    const int seq = item >> 5, sc = item & 31, b = seq >> 2, h = seq & 3; const int g = lane >> 4, c = lane & 15;
    const int tok0 = b * SEQ + sc * 256; const int chunk0 = tok0 >> 4;
    const bf16* KUT = (const bf16*)(ws + WS_KUT); const bf16* VT = (const bf16*)(ws + WS_VT); const float* DEC = (const float*)(ws + WS_DEC);
    const bf16* QI = (const bf16*)(ws + WS_QI); const bf16* GS = (const bf16*)(ws + WS_GS);
    bf16* MIX = (bf16*)(ws + WS_MIX);
    LAS float* ot = (LAS float*)(lds + P3_OT);
    f32x4 S[8];
    {
        const bf16* Ub = (const bf16*)(ws + WS_U) + (size_t)(seq * 32) * 16384 + (size_t)(wave * 8 * 64 + lane) * 4;
        const float* Db = (const float*)(ws + WS_DTOT) + (size_t)(seq * 32) * 128 + 8 * g;
        f32x4 W[8];
#pragma unroll
        for (int j = 0; j < 8; ++j) { S[j] = (f32x4){0.f, 0.f, 0.f, 0.f}; W[j] = (f32x4){1.f, 1.f, 1.f, 1.f}; }
        for (int k = sc - 1; k >= 0; k -= 2) {
            const int k2 = k > 0 ? k - 1 : 0;
            f32x4 u[8], d[8], u2[8], d2[8];
#pragma unroll
            for (int j = 0; j < 8; ++j) { const u32x2 a_ = *(const u32x2*)(Ub + (size_t)k * 16384 + j * 256), b_ = *(const u32x2*)(Ub + (size_t)k2 * 16384 + j * 256);
                u[j] = (f32x4){__uint_as_float(a_.x << 16), __uint_as_float(a_.x & 0xffff0000u), __uint_as_float(a_.y << 16), __uint_as_float(a_.y & 0xffff0000u)};
                u2[j] = (f32x4){__uint_as_float(b_.x << 16), __uint_as_float(b_.x & 0xffff0000u), __uint_as_float(b_.y << 16), __uint_as_float(b_.y & 0xffff0000u)};
                d[j] = *(const f32x4*)(Db + k * 128 + 32 * (j >> 1) + 4 * (j & 1)); d2[j] = *(const f32x4*)(Db + k2 * 128 + 32 * (j >> 1) + 4 * (j & 1)); }
            float live = 0.f;
#pragma unroll
            for (int j = 0; j < 8; ++j) { S[j] += W[j] * u[j]; W[j] = W[j] * d[j]; if (k > 0) { S[j] += W[j] * u2[j]; W[j] = W[j] * d2[j]; } live += (W[j][0] + W[j][1]) + (W[j][2] + W[j][3]); }
            if (!__any(live != 0.f)) break;
        }
    }
    const f32x4 n0 = *(const f32x4*)(nw + h * 128 + (tid & 15) * 8), n1 = *(const f32x4*)(nw + h * 128 + (tid & 15) * 8 + 4);
    u32x4 s_kut[2], s_vt[2], s_qi[2], s_gs[2]; float s_dinv[2]; f32x4 s_dec = (f32x4){0.f, 0.f, 0.f, 0.f};
#define P3_LOAD(q) do { \
        _Pragma("unroll") for (int it = 0; it < 2; ++it) { const int idx = tid + NTHR * it; const int ckl = idx >> 8, p = idx & 255; const int ckg = chunk0 + 4 * (q) + ckl; \
            s_kut[it] = *(const u32x4*)(KUT + ((size_t)ckg * 512 + h * 128) * 16 + p * 8); s_vt[it] = *(const u32x4*)(VT + ((size_t)ckg * 512 + h * 128) * 16 + p * 8); \
            const size_t to = (size_t)(ckg * 16 + (p >> 4)) * 512 + h * 128 + (p & 15) * 8; s_qi[it] = *(const u32x4*)(QI + to); s_dinv[it] = 1.0f / DEC[(size_t)ckg * 512 + h * 128 + (p >> 1)]; \
            s_gs[it] = *(const u32x4*)(GS + (size_t)(tok0 + 64 * (q) + (idx >> 4)) * 512 + h * 128 + (idx & 15) * 8); } \
        if (tid < 128) s_dec = *(const f32x4*)(DEC + (size_t)(chunk0 + 4 * (q) + (tid >> 5)) * 512 + h * 128 + 4 * (tid & 31)); \
    } while (0)
    P3_LOAD(0);
    for (int q = 0; q < 4; ++q) {
#pragma unroll
        for (int it = 0; it < 2; ++it) { const int idx = tid + NTHR * it; const int ckl = idx >> 8, p = idx & 255;
            LAS unsigned char* d = lds + ckl * 4096 + kut_lds_off(p);
            *(LAS u32x2*)d = (u32x2){s_kut[it].x, s_kut[it].y}; *(LAS u32x2*)(d + 128) = (u32x2){s_kut[it].z, s_kut[it].w};
            const int tl = p >> 4, dg = p & 15; const int fo = ckl * 4096 + (((dg >> 2) * 4 + (dg & 3)) * 16 + tl) * 16;
            *(LAS u32x4*)(lds + P3_QI + fo) = s_qi[it]; *(LAS u32x4*)(lds + P3_VT + idx * 16) = s_vt[it];
            { const int d = p >> 1; LAS unsigned char* kb = lds + P3_KX + ckl * 4096 + ((d >> 3) * 16 + 8 * (p & 1)) * 16 + (d & 7) * 2; const float di = s_dinv[it];
#pragma unroll
              for (int e8 = 0; e8 < 8; ++e8) { const unsigned wv = s_kut[it][e8 >> 1]; const float kuv = __uint_as_float((e8 & 1) ? (wv & 0xffff0000u) : (wv << 16));
                  *(LAS unsigned short*)(kb + e8 * 16) = cvt_bf16(kuv * di); } } }
        if (tid < 128) *(LAS f32x4*)(lds + P3_DEC + tid * 16) = s_dec;
        u32x4 gsc[2];
        gsc[0] = s_gs[0]; gsc[1] = s_gs[1];
        __syncthreads();
        if (q < 3) P3_LOAD(q + 1);
#pragma unroll 1
        for (int ckl = 0; ckl < 4; ++ckl) {
            const s16x4 vbc = *(const LAS s16x4*)(lds + P3_VT + ckl * 4096 + ((16 * wave + c) * 16 + 4 * g) * 2);
            bf16x8 kxf[4], qif[4];
#pragma unroll
            for (int kk = 0; kk < 4; ++kk) { const int fo = ckl * 4096 + ((kk * 4 + g) * 16 + c) * 16; kxf[kk] = *(const LAS bf16x8*)(lds + P3_KX + fo); qif[kk] = *(const LAS bf16x8*)(lds + P3_QI + fo); }
            f32x4 pt = (f32x4){0.f, 0.f, 0.f, 0.f};
#pragma unroll
            for (int kk = 0; kk < 4; ++kk) pt = __builtin_amdgcn_mfma_f32_16x16x32_bf16(kxf[kk], qif[kk], pt, 0, 0, 0);
#pragma unroll
            for (int i = 0; i < 4; ++i) if (4 * g + i > c) pt[i] = 0.f;
            u32x2 pw; pw.x = cvt_pk_bf16(pt[0], pt[1]); pw.y = cvt_pk_bf16(pt[2], pt[3]);
            f32x4 o0 = __builtin_amdgcn_mfma_f32_16x16x16bf16_1k(__builtin_bit_cast(s16x4, pw), vbc, (f32x4){0.f, 0.f, 0.f, 0.f}, 0, 0, 0);
            f32x4 o1 = (f32x4){0.f, 0.f, 0.f, 0.f};
#pragma unroll
            for (int j = 0; j < 8; ++j) {
                const bf16x8 qq = qif[j >> 1];
                const s16x4 qa = (j & 1) ? (s16x4){qq[4], qq[5], qq[6], qq[7]} : (s16x4){qq[0], qq[1], qq[2], qq[3]};
                u32x2 sw; sw.x = cvt_pk_bf16(S[j][0], S[j][1]); sw.y = cvt_pk_bf16(S[j][2], S[j][3]);
                if (j & 1) o1 = __builtin_amdgcn_mfma_f32_16x16x16bf16_1k(qa, __builtin_bit_cast(s16x4, sw), o1, 0, 0, 0);
                else       o0 = __builtin_amdgcn_mfma_f32_16x16x16bf16_1k(qa, __builtin_bit_cast(s16x4, sw), o0, 0, 0, 0);
            }
#pragma unroll
            for (int j = 0; j < 8; ++j) {
                const s16x4 ka = *(const LAS s16x4*)(lds + ckl * 4096 + ((j * 4 + g) * 16 + c) * 8);
                const f32x4 dc = *(const LAS f32x4*)(lds + P3_DEC + (ckl * 128 + 32 * (j >> 1) + 8 * g + 4 * (j & 1)) * 4);
                S[j] = __builtin_amdgcn_mfma_f32_16x16x16bf16_1k(ka, vbc, S[j] * dc, 0, 0, 0);
            }
            const f32x4 o = o0 + o1;
            LAS float* op = ot + (ckl * 16 + 4 * g) * OPITCH + 16 * wave + c;
#pragma unroll
            for (int i = 0; i < 4; ++i) op[i * OPITCH] = o[i];
        }
        __syncthreads();
#pragma unroll
        for (int it = 0; it < 2; ++it) {
            const int idx = tid + NTHR * it; const int tl = idx >> 4, d8 = (idx & 15) * 8; const int tok = tok0 + q * 64 + tl;
            const f32x4 v0 = *(const LAS f32x4*)(ot + tl * OPITCH + d8), v1 = *(const LAS f32x4*)(ot + tl * OPITCH + d8 + 4);
            const u32x4 gq = gsc[it];
            float ss = (v0[0] * v0[0] + v0[1] * v0[1]) + (v0[2] * v0[2] + v0[3] * v0[3]) + (v1[0] * v1[0] + v1[1] * v1[1]) + (v1[2] * v1[2] + v1[3] * v1[3]);
            ss += __shfl_xor(ss, 1); ss += __shfl_xor(ss, 2); ss += __shfl_xor(ss, 4); ss += __shfl_xor(ss, 8);
            const float rs = __builtin_amdgcn_rsqf(ss * (1.0f / 128.0f) + EPS);
            f32x4 y0 = v0 * rs * n0, y1 = v1 * rs * n1;
            y0[0] *= __uint_as_float(gq[0] << 16); y0[1] *= __uint_as_float(gq[0] & 0xffff0000u); y0[2] *= __uint_as_float(gq[1] << 16); y0[3] *= __uint_as_float(gq[1] & 0xffff0000u);
            y1[0] *= __uint_as_float(gq[2] << 16); y1[1] *= __uint_as_float(gq[2] & 0xffff0000u); y1[2] *= __uint_as_float(gq[3] << 16); y1[3] *= __uint_as_float(gq[3] & 0xffff0000u);
            u32x4 w; w.x = cvt_pk_bf16(y0[0], y0[1]); w.y = cvt_pk_bf16(y0[2], y0[3]); w.z = cvt_pk_bf16(y1[0], y1[1]); w.w = cvt_pk_bf16(y1[2], y1[3]);
            *(u32x4*)(MIX + (size_t)tok * 1024 + 512 + h * 128 + d8) = w;
        }
    }
    __syncthreads();
#undef P3_LOAD
}

__device__ __forceinline__ int affine_item(int c) { const int pm = 8 * (c & 7) + ((c >> 3) & 7), h = c >> 6; return (((pm >> 5) * 4 + h) << 5) + (pm & 31); }
__device__ __forceinline__ void attn_merge(unsigned char* ws, int gt, int NGT) {
    const bool aff = (NGT == 256 * NTHR); const int c_ = gt / NTHR, tl_ = gt % NTHR; const int tokb_ = 256 * (8 * (c_ & 7) + ((c_ >> 3) & 7)) + 64 * (c_ >> 6);
    const float* L = (const float*)(ws + WS_LSE); bf16* MIX = (bf16*)(ws + WS_MIX);
    const bf16* O0 = (const bf16*)(ws + WS_OP0); const bf16* O1 = (const bf16*)(ws + WS_OP1); const bf16* O2 = (const bf16*)(ws + WS_OP2);
    for (int idx = gt; idx < M * 64; idx += NGT) {
        const int k_ = idx / NGT, il_ = tl_ + NTHR * k_;
        const int tok = aff ? tokb_ + (il_ >> 6) : idx >> 6, hh = aff ? (il_ >> 3) & 7 : (idx >> 3) & 7, ch = aff ? il_ & 7 : idx & 7;
        const int bb = tok >> 13, tt = tok & (SEQ - 1); const size_t hb = (size_t)(bb * 8 + hh) * SEQ;
        const float l0 = L[hb + tt], l1 = L[(size_t)16 * SEQ + hb + (size_t)(tt & 3) * (SEQ >> 2) + (tt >> 2)], l2 = L[(size_t)32 * SEQ + hb + (size_t)(tt & 15) * (SEQ >> 4) + (tt >> 4)];
        const float mx = fmaxf(l0, fmaxf(l1, l2));
        float w0 = __builtin_amdgcn_exp2f(l0 - mx), w1 = __builtin_amdgcn_exp2f(l1 - mx), w2 = __builtin_amdgcn_exp2f(l2 - mx);
        const float inv = 1.0f / (w0 + w1 + w2); w0 *= inv; w1 *= inv; w2 *= inv;
        const size_t off = (size_t)tok * 512 + hh * 64 + ch * 8;
        const u32x4 a = __builtin_nontemporal_load((const u32x4*)(O0 + off)), bq = __builtin_nontemporal_load((const u32x4*)(O1 + off)), cq = __builtin_nontemporal_load((const u32x4*)(O2 + off));
        u32x4 r;
#pragma unroll
        for (int k = 0; k < 4; ++k) {
            const float lo = w0 * __uint_as_float(a[k] << 16) + w1 * __uint_as_float(bq[k] << 16) + w2 * __uint_as_float(cq[k] << 16);
            const float hi = w0 * __uint_as_float(a[k] & 0xffff0000u) + w1 * __uint_as_float(bq[k] & 0xffff0000u) + w2 * __uint_as_float(cq[k] & 0xffff0000u);
            r[k] = cvt_pk_bf16(lo, hi);
        }
        *(u32x4*)(MIX + (size_t)tok * 1024 + hh * 64 + ch * 8) = r;
    }
}

__global__ void __launch_bounds__(NTHR, 2) fwd_megakernel(Args args) {
    extern __shared__ __attribute__((aligned(16))) unsigned char lds_raw[];
    LAS unsigned char* lds = (LAS unsigned char*)lds_raw;
    const int G = gridDim.x, bx = blockIdx.x;
    const int NGW = G * NWAVES, NGT = G * NTHR;
    unsigned char* ws = args.ws;
    volatile LAS unsigned* MISC = (volatile LAS unsigned*)(lds + LDS_BYTES - 128);
    if (threadIdx.x < 32) MISC[threadIdx.x] = 0u;
    __syncthreads();
    const XcdBarrier bar = xcd_barrier_post((unsigned*)(ws + WS_BAR), MISC + 8);
#define GRID_SYNC() xcd_barrier(bar)
#define PHASE_IDS() int tid = threadIdx.x; asm volatile("" : "+v"(tid)); const int lane = tid & 63, wave = __builtin_amdgcn_readfirstlane(tid >> 6); const int gw = bx * NWAVES + wave, gt = bx * NTHR + tid; (void)lane; (void)gw; (void)gt

    { PHASE_IDS(); p0_prologue(args, lds, gw, NGW, wave, lane);
    }
    GRID_SYNC();
    {
        pg8::Gemm g{(const pg8::bf16_t*)(ws + WS_XN), (const pg8::bf16_t*)(ws + WS_WIN), M, NIN, DM}; pg8::StaticOrder S; S.init(M, NIN, G, bx);
        pg8::EpiInProj E{ws};
        pg8::gemm_phase<pg8::EpiInProj, pg8::StaticOrder, true, true>(lds, g, S, E);
        if (bx >= 128) { PHASE_IDS(); convert_rest(args, lds, (bx - 128) * NWAVES + wave, (G - 128) * NWAVES, wave, lane); }
    }
    GRID_SYNC();
    { PHASE_IDS(); for (int it = bx; it < 256; it += G) hgrn_pass1(affine_item(it), lds, ws, tid, wave, lane);
    }
    { PHASE_IDS(); attn_phase(lds, ws, bx, G, tid, wave, lane);
    }
    GRID_SYNC();
    { PHASE_IDS(); for (int it = bx; it < 256; it += G) hgrn_pass3(affine_item(it), lds, ws, args.in[4], tid, wave, lane);
    }
    { PHASE_IDS(); attn_merge(ws, gt, NGT);
    }
    GRID_SYNC();
    {
        pg8::Gemm g{(const pg8::bf16_t*)(ws + WS_MIX), (const pg8::bf16_t*)(ws + WS_WOUT), M, DM, DM}; pg8::StaticOrder S; S.init(M, DM, G, bx);
        pg8::EpiOutProj E{args.in[0], (bf16*)(ws + WS_Q), (float*)(ws + WS_SS1)};
        pg8::gemm_phase<pg8::EpiOutProj, pg8::StaticOrder, true, true>(lds, g, S, E);
        { PHASE_IDS(); prefetch_lines(ws + WS_WGU, (NGU * DM * 2) / 128, gt, NGT); }
    }
    GRID_SYNC();
    {
        pg8::Gemm g{(const pg8::bf16_t*)(ws + WS_Q), (const pg8::bf16_t*)(ws + WS_WGU), M, NGU, DM}; pg8::StaticOrder S; S.init(M, NGU, G, bx);
        pg8::EpiGateUp E{(bf16*)(ws + WS_ACT), (const float*)(ws + WS_SS1)};
        pg8::gemm_phase<pg8::EpiGateUp, pg8::StaticOrder, true, true>(lds, g, S, E);
        { PHASE_IDS(); prefetch_lines(ws + WS_WDN, (DM * FFH * 2) / 128, gt, NGT); }
    }
    GRID_SYNC();
    {
        pg8::Gemm g{(const pg8::bf16_t*)(ws + WS_ACT), (const pg8::bf16_t*)(ws + WS_WDN), M, DM, FFH}; pg8::StaticOrder S; S.init(M, DM, G, bx);
        pg8::EpiDownNorm E{(const bf16*)(ws + WS_Q), args.out, (float*)(ws + WS_SS2), (unsigned*)(ws + WS_PCNT), args.in[9]};
        pg8::gemm_phase<pg8::EpiDownNorm, pg8::StaticOrder, false, true>(lds, g, S, E);
    }
}

extern "C" void kernel_launch(void* const* d_in, const int* in_sizes, int n_in, void* d_out, int out_size, void* d_ws, size_t ws_size, hipStream_t stream) {
    static int grid = 0;
    if (grid == 0) {
        if (n_in != 10 || in_sizes[0] != M * DM || out_size != M * DM || ws_size < WS_END) { fprintf(stderr, "kernel_launch: unexpected shapes (n_in %d in0 %d out %d ws %zu)\n", n_in, n_in > 0 ? in_sizes[0] : -1, out_size, ws_size); grid = -1; return; }
        int dev = 0, cus = 0, per_cu = 0;
        hipGetDevice(&dev); hipDeviceGetAttribute(&cus, hipDeviceAttributeMultiprocessorCount, dev);
        hipFuncSetAttribute((const void*)fwd_megakernel, hipFuncAttributeMaxDynamicSharedMemorySize, LDS_BYTES);
        hipOccupancyMaxActiveBlocksPerMultiprocessor(&per_cu, (const void*)fwd_megakernel, NTHR, LDS_BYTES);
        if (per_cu < 1) { fprintf(stderr, "kernel_launch: occupancy query says %d blocks per CU; nothing launched\n", per_cu); grid = -1; return; }
        (void)hipGetLastError();
        grid = cus * 1;
        if (grid != 256) { fprintf(stderr, "kernel_launch: this kernel needs exactly 256 CUs (got %d)\n", cus); grid = -1; return; }
    }
    if (grid < 0) return;
    if (hipMemsetAsync(d_ws, 0, WS_ZERO_BYTES, stream) != hipSuccess) { fprintf(stderr, "kernel_launch: memset failed\n"); return; }
    Args a{};
    for (int i = 0; i < 10; ++i) a.in[i] = (const float*)d_in[i];
    a.out = (float*)d_out; a.ws = (unsigned char*)d_ws;
    void* kargs[] = {&a};
    hipError_t e = hipLaunchCooperativeKernel((const void*)fwd_megakernel, dim3(grid), dim3(NTHR), kargs, LDS_BYTES, stream);
    if (e != hipSuccess) fprintf(stderr, "cooperative launch failed: %s (grid %d)\n", hipGetErrorString(e), grid);
}
```
